# Optimizing an MI355X kernel written in HIP

```python
import math
import jax, jax.numpy as jnp
from jax import lax
import numpy as np

D_MODEL = 1024
BATCH = 4
SEQ = 4096
DEPTH = 2

H_MLA = 8
MLA_NOPE = 64
MLA_ROPE = 32
MLA_V = 64
Q_LORA = 384
KV_LORA = 256
H_DSA = 4
DSA_DIM = 64
H_IDX = 8
D_IDX = 32
TOPK_MAX = 256
H_DIFF = 4
DIFF_QK = 32
DIFF_V = 2 * DIFF_QK
D_MIX = H_MLA * MLA_V + H_DSA * DSA_DIM + H_DIFF * DIFF_V
D_FF = 4 * D_MODEL
N_BUCKETS = 32
MAX_DISTANCE = 128
N_BIAS_HEADS = H_DSA + H_DIFF
ROPE_BASE = 10000.0
Q_BLOCK = 128
EPS = 1e-6
NEG = -1e30

IN_SPLITS = (
    Q_LORA, KV_LORA, MLA_ROPE,
    H_DSA * DSA_DIM, DSA_DIM, DSA_DIM,
    H_IDX * D_IDX, D_IDX, H_IDX,
    H_DIFF * 2 * DIFF_QK, H_DIFF * 2 * DIFF_QK, H_DIFF * DIFF_V,
)
IN_OFFSETS = tuple(int(o) for o in np.cumsum(IN_SPLITS)[:-1])
N_IN = int(sum(IN_SPLITS))

kernel_name = "hymba_mla_dsa_diff_trunk"


def _rmsnorm(x, g):
    xf = x.astype(jnp.float32)
    y = xf * lax.rsqrt(jnp.mean(xf * xf, axis=-1, keepdims=True) + EPS)
    return (y * g.astype(jnp.float32)).astype(x.dtype)


def _rope(x, pos):
    half = x.shape[-1] // 2
    freqs = ROPE_BASE ** (-jnp.arange(half, dtype=jnp.float32) / half)
    ang = pos.astype(jnp.float32)[..., None] * freqs
    ang = ang.reshape(ang.shape[:2] + (1,) * (x.ndim - 3) + (half,))
    cos, sin = jnp.cos(ang), jnp.sin(ang)
    x1 = x[..., :half].astype(jnp.float32)
    x2 = x[..., half:].astype(jnp.float32)
    return jnp.concatenate([x1 * cos - x2 * sin, x1 * sin + x2 * cos], axis=-1).astype(x.dtype)


def _t5_bucket(rel):
    n = jnp.maximum(rel, 0)
    max_exact = N_BUCKETS // 2
    nf = jnp.maximum(n, 1).astype(jnp.float32)
    large = max_exact + (jnp.log(nf / max_exact) / math.log(MAX_DISTANCE / max_exact)
                         * (N_BUCKETS - max_exact)).astype(jnp.int32)
    large = jnp.minimum(large, N_BUCKETS - 1)
    return jnp.where(n < max_exact, n, large)


def _unblock(y):
    nb, b, qb = y.shape[:3]
    return jnp.moveaxis(y, 0, 1).reshape(b, nb * qb, -1)


def _mla(c_q, c_kv, k_rope_raw, pos, q_norm, w_uq, kv_norm, w_ukv):
    B, S, _ = c_q.shape
    q = (_rmsnorm(c_q, q_norm) @ w_uq).reshape(B, S, H_MLA, MLA_NOPE + MLA_ROPE)
    q_nope = q[..., :MLA_NOPE]
    q_rope = _rope(q[..., MLA_NOPE:], pos)
    kv = (_rmsnorm(c_kv, kv_norm) @ w_ukv).reshape(B, S, H_MLA, MLA_NOPE + MLA_V)
    k_nope, v = kv[..., :MLA_NOPE], kv[..., MLA_NOPE:]
    k_rope = _rope(k_rope_raw, pos)
    scale = (MLA_NOPE + MLA_ROPE) ** -0.5
    kidx = jnp.arange(S)

    def block(i):
        start = i * Q_BLOCK
        qn = lax.dynamic_slice_in_dim(q_nope, start, Q_BLOCK, 1)
        qr = lax.dynamic_slice_in_dim(q_rope, start, Q_BLOCK, 1)
        logits = (jnp.einsum('bqhd,bkhd->bhqk', qn, k_nope)
                  + jnp.einsum('bqhr,bkr->bhqk', qr, k_rope)).astype(jnp.float32) * scale
        qidx = start + jnp.arange(Q_BLOCK)
        logits = jnp.where(kidx[None, :] <= qidx[:, None], logits, NEG)
        p = jax.nn.softmax(logits, axis=-1).astype(v.dtype)
        return jnp.einsum('bhqk,bkhd->bqhd', p, v)

    return _unblock(lax.map(block, jnp.arange(S // Q_BLOCK)))


def _dsa(q, k, v, q_idx, k_idx, w_idx, pos, table):
    B, S, _ = q.shape
    q = q.reshape(B, S, H_DSA, DSA_DIM)
    q_idx = q_idx.reshape(B, S, H_IDX, D_IDX)
    n_sel = min(TOPK_MAX, S // 4)
    idx_scale = (D_IDX ** -0.5) * (H_IDX ** -0.5)
    scale = DSA_DIM ** -0.5
    kidx = jnp.arange(S)
    gather = jax.vmap(lambda a, i: a[i])

    def block(i):
        start = i * Q_BLOCK
        qb = lax.dynamic_slice_in_dim(q, start, Q_BLOCK, 1)
        qib = lax.dynamic_slice_in_dim(q_idx, start, Q_BLOCK, 1)
        wb = lax.dynamic_slice_in_dim(w_idx, start, Q_BLOCK, 1)
        pq = lax.dynamic_slice_in_dim(pos, start, Q_BLOCK, 1)
        qidx = start + jnp.arange(Q_BLOCK)
        s = jax.nn.relu(jnp.einsum('bqhd,bkd->bqhk', qib, k_idx).astype(jnp.float32))
        score = jnp.einsum('bqh,bqhk->bqk', wb.astype(jnp.float32), s) * idx_scale
        score = jnp.where((kidx[None, :] <= qidx[:, None])[None], score, NEG)
        _, sel = lax.top_k(score, n_sel)
        valid = sel <= qidx[None, :, None]
        k_sel = gather(k, sel)
        v_sel = gather(v, sel)
        p_sel = gather(pos, sel)
        bias = table[_t5_bucket(pq[:, :, None] - p_sel)][..., :H_DSA]
        logits = (jnp.einsum('bqhd,bqnd->bhqn', qb, k_sel).astype(jnp.float32) * scale
                  + jnp.transpose(bias, (0, 3, 1, 2)).astype(jnp.float32))
        logits = jnp.where(valid[:, None], logits, NEG)
        p = jax.nn.softmax(logits, axis=-1).astype(v.dtype)
        return jnp.einsum('bhqn,bqnd->bqhd', p, v_sel)

    return _unblock(lax.map(block, jnp.arange(S // Q_BLOCK)))


def _diff(q, k, v, pos, table, lam_params, subln, lam_init):
    B, S, _ = q.shape
    q = q.reshape(B, S, H_DIFF, 2, DIFF_QK)
    k = k.reshape(B, S, H_DIFF, 2, DIFF_QK)
    v = v.reshape(B, S, H_DIFF, DIFF_V)
    lp = lam_params.astype(jnp.float32)
    lam = jnp.exp(jnp.sum(lp[0] * lp[1])) - jnp.exp(jnp.sum(lp[2] * lp[3])) + lam_init
    scale = DIFF_QK ** -0.5
    kidx = jnp.arange(S)

    def block(i):
        start = i * Q_BLOCK
        qb = lax.dynamic_slice_in_dim(q, start, Q_BLOCK, 1)
        pq = lax.dynamic_slice_in_dim(pos, start, Q_BLOCK, 1)
        qidx = start + jnp.arange(Q_BLOCK)
        logits = jnp.einsum('bqhcd,bkhcd->bchqk', qb, k).astype(jnp.float32) * scale
        bias = table[_t5_bucket(pq[:, :, None] - pos[:, None, :])][..., H_DSA:]
        logits = logits + jnp.transpose(bias, (0, 3, 1, 2)).astype(jnp.float32)[:, None]
        logits = jnp.where(kidx[None, :] <= qidx[:, None], logits, NEG)
        p = jax.nn.softmax(logits, axis=-1)
        a = (p[:, 0] - lam * p[:, 1]).astype(v.dtype)
        return jnp.einsum('bhqk,bkhd->bqhd', a, v)

    o = _unblock(lax.map(block, jnp.arange(S // Q_BLOCK))).reshape(B, S, H_DIFF, DIFF_V)
    o = _rmsnorm(o, subln) * (1.0 - lam_init)
    return o.reshape(B, S, H_DIFF * DIFF_V)


def setup_inputs(seed: int = 0) -> dict:
    key = jax.random.key(seed)
    ks = jax.random.split(key, 16)
    f32 = jnp.float32

    def nrm(k, shape, fan_in):
        return jax.random.normal(k, shape, f32) * (fan_in ** -0.5)

    def gain(k, shape):
        return 1.0 + 0.05 * jax.random.normal(k, shape, f32)

    return {
        "x": jax.random.normal(ks[0], (BATCH, SEQ, D_MODEL), f32),
        "positions": jnp.broadcast_to(jnp.arange(SEQ, dtype=jnp.int32), (BATCH, SEQ)),
        "rel_bias": 0.5 * jax.random.normal(ks[1], (N_BUCKETS, N_BIAS_HEADS), f32),
        "norm_attn": gain(ks[2], (DEPTH, D_MODEL)),
        "w_in": nrm(ks[3], (DEPTH, D_MODEL, N_IN), D_MODEL),
        "q_norm": gain(ks[4], (DEPTH, Q_LORA)),
        "w_uq": nrm(ks[5], (DEPTH, Q_LORA, H_MLA * (MLA_NOPE + MLA_ROPE)), Q_LORA),
        "kv_norm": gain(ks[6], (DEPTH, KV_LORA)),
        "w_ukv": nrm(ks[7], (DEPTH, KV_LORA, H_MLA * (MLA_NOPE + MLA_V)), KV_LORA),
        "diff_lambda": 0.1 * jax.random.normal(ks[8], (DEPTH, 4, DIFF_QK), f32),
        "diff_subln": gain(ks[9], (DEPTH, DIFF_V)),
        "w_out": nrm(ks[10], (DEPTH, D_MIX, D_MODEL), D_MIX),
        "norm_mlp": gain(ks[11], (DEPTH, D_MODEL)),
        "w_up": nrm(ks[12], (DEPTH, D_MODEL, D_FF), D_MODEL),
        "w_down": nrm(ks[13], (DEPTH, D_FF, D_MODEL), D_FF),
        "norm_final": gain(ks[14], (D_MODEL,)),
    }


def reference(x, positions, rel_bias, norm_attn, w_in, q_norm, w_uq, kv_norm, w_ukv,
              diff_lambda, diff_subln, w_out, norm_mlp, w_up, w_down, norm_final):
    for l in range(DEPTH):
        h = _rmsnorm(x, norm_attn[l])
        proj = h @ w_in[l]
        (c_q, c_kv, k_rope_raw,
         q_b, k_b, v_b, qi_b, ki_b, wi_b,
         q_c, k_c, v_c) = jnp.split(proj, IN_OFFSETS, axis=-1)
        o_a = _mla(c_q, c_kv, k_rope_raw, positions, q_norm[l], w_uq[l], kv_norm[l], w_ukv[l])
        o_b = _dsa(q_b, k_b, v_b, qi_b, ki_b, wi_b, positions, rel_bias)
        lam_init = 0.8 - 0.6 * math.exp(-0.3 * l)
        o_c = _diff(q_c, k_c, v_c, positions, rel_bias, diff_lambda[l], diff_subln[l], lam_init)
        mix = jnp.concatenate([o_a, o_b, o_c], axis=-1)
        x = x + mix @ w_out[l]
        h = _rmsnorm(x, norm_mlp[l])
        x = x + jnp.square(jax.nn.relu(h @ w_up[l])) @ w_down[l]
    return _rmsnorm(x, norm_final)
```

```cpp
#include <hip/hip_runtime.h>
#define PROBE 0
#include <stdint.h>
#include <stdio.h>

constexpr int NB = 4, S = 4096, T = NB * S, DM = 1024, DEPTH = 2;
constexpr int H_MLA = 8, H_DSA = 4, H_IDX = 8, D_IDX = 32, H_DIFF = 4;
constexpr int Q_LORA = 384, KV_LORA = 256;
constexpr int N_IN = 2120, N_INP = 2304, DFF = 4096, NQ_UP = 768, NKV_UP = 1024;
constexpr int NSEL = 256;
constexpr float EPS = 1e-6f, LOG2E = 1.4426950408889634f;
constexpr int NT64 = S / 64;

#define GAS __attribute__((address_space(1)))
typedef unsigned short bf16_t;
typedef short bf16x8 __attribute__((ext_vector_type(8)));
typedef float f32x4 __attribute__((ext_vector_type(4)));
typedef float f32x16 __attribute__((ext_vector_type(16)));
typedef unsigned u32x4 __attribute__((ext_vector_type(4)));
typedef unsigned u32x2 __attribute__((ext_vector_type(2)));

constexpr size_t MiB = 1u << 20;
constexpr size_t WS_CTL = 0;
constexpr size_t WS_RSA = 1 * MiB;
constexpr size_t WS_RSB = 3 * MiB;
constexpr size_t WS_RSCQ = 5 * MiB;
constexpr size_t WS_RSCKV = 6 * MiB;
constexpr size_t WS_MISC = 6 * MiB + 512 * 1024;
constexpr size_t WS_W = 7 * MiB;
constexpr size_t SZ_WIN = (size_t)N_INP * DM * 2, SZ_WUQ = (size_t)NQ_UP * Q_LORA * 2, SZ_WUKV = (size_t)NKV_UP * KV_LORA * 2,
                 SZ_WOUT = (size_t)DM * DM * 2, SZ_WUP = (size_t)DFF * DM * 2, SZ_WDN = (size_t)DM * DFF * 2;
constexpr size_t WS_WIN = WS_W, WS_WUQ = WS_WIN + 2 * SZ_WIN, WS_WUKV = WS_WUQ + 2 * SZ_WUQ, WS_WOUT = WS_WUKV + 2 * SZ_WUKV,
                 WS_WUP = WS_WOUT + 2 * SZ_WOUT, WS_WDN = WS_WUP + 2 * SZ_WUP, WS_WEND = WS_WDN + 2 * SZ_WDN;
constexpr size_t WS_XB = 55 * MiB;
static_assert(WS_WEND <= WS_XB, "weights");
constexpr size_t WS_OV = 87 * MiB;
constexpr size_t WS_U = WS_OV;
constexpr size_t WS_CQ = WS_OV;
constexpr size_t WS_CKV = WS_CQ + 12 * MiB;
constexpr size_t WS_QB = WS_CKV + 8 * MiB;
constexpr size_t WS_QI = WS_QB + 8 * MiB;
constexpr size_t WS_QC = WS_QI + 8 * MiB;
constexpr size_t WS_KI = WS_QC + 8 * MiB;
constexpr size_t WS_WI = WS_KI + 1 * MiB;
constexpr size_t WS_KR = WS_WI + 512 * 1024;
constexpr size_t WS_KB = WS_KR + 1 * MiB;
constexpr size_t WS_VB = WS_KB + 2 * MiB;
constexpr size_t WS_KC = WS_VB + 2 * MiB;
constexpr size_t WS_VC = WS_KC + 8 * MiB;
constexpr size_t WS_QA = WS_VC + 8 * MiB;
constexpr size_t WS_KN = WS_QA + 24 * MiB;
constexpr size_t WS_VA = WS_KN + 16 * MiB;
constexpr size_t WS_BM = WS_VA + 16 * MiB;
constexpr size_t WS_MIX = WS_BM + 8 * MiB;
constexpr size_t WS_END = WS_MIX + 32 * MiB;
constexpr size_t WS_ROPE = 250 * MiB;
static_assert(WS_END <= WS_ROPE && WS_ROPE + (size_t)T * 128 <= 256 * MiB && WS_U + (size_t)T * DFF * 2 <= 256 * MiB, "workspace");

struct P {
    const float *x, *rel_bias, *norm_attn, *w_in, *q_norm, *w_uq, *kv_norm, *w_ukv, *diff_lambda, *diff_subln, *w_out, *norm_mlp, *w_up, *w_down, *norm_final;
    const int* pos;
    float* out;
    unsigned char* ws;
};

__device__ __forceinline__ int phase_tid(int wave) { int t; asm volatile("v_mbcnt_lo_u32_b32 %0, -1, 0\n\tv_mbcnt_hi_u32_b32 %0, -1, %0" : "=v"(t)); return wave * 64 + t; }
__device__ __forceinline__ unsigned f2bf(float f) { unsigned u = __builtin_bit_cast(unsigned, f); return (u + 0x7fffu + ((u >> 16) & 1u)) >> 16; }
__device__ __forceinline__ float bf2f(unsigned b) { return __builtin_bit_cast(float, (b & 0xffffu) << 16); }
__device__ __forceinline__ unsigned pk2(float lo, float hi) { unsigned r; asm("v_cvt_pk_bf16_f32 %0, %1, %2" : "=v"(r) : "v"(lo), "v"(hi)); return r; }
__device__ __forceinline__ u32x4 pk8(const float (&v)[8]) { u32x4 w; w.x = pk2(v[0], v[1]); w.y = pk2(v[2], v[3]); w.z = pk2(v[4], v[5]); w.w = pk2(v[6], v[7]); return w; }
__device__ __forceinline__ void unpk8(u32x4 w, float (&v)[8]) {
    v[0] = bf2f(w.x); v[1] = bf2f(w.x >> 16); v[2] = bf2f(w.y); v[3] = bf2f(w.y >> 16); v[4] = bf2f(w.z); v[5] = bf2f(w.z >> 16); v[6] = bf2f(w.w); v[7] = bf2f(w.w >> 16); }

__device__ __forceinline__ size_t kimg(int g, int s, int d, int nch) { return (((size_t)g * NT64 + (s >> 6)) * nch + (d >> 3)) * 512 + (s & 63) * 8 + (d & 7); }
__device__ __forceinline__ size_t vimg(int g, int s, int d) { return (((size_t)g * NT64 + (s >> 6)) * 2 + (d >> 5)) * 2048 + (s & 63) * 32 + (d & 31); }

__device__ __forceinline__ int t5_bucket(int rel) {
    const int n = rel > 0 ? rel : 0;
    if (n < 16) return n;
    const float nf = (float)n;
    int large = 16 + (int)(logf(nf / 16.f) / 2.0794415416798357f * 16.f);
    return large < 31 ? large : 31;
}
__device__ __forceinline__ float lam_init_of(int l) { return l == 0 ? 0.2f : (float)(0.8 - 0.6 * 0.7408182206817179); }
__device__ __forceinline__ float rope_freq(int i) { return powf(10000.f, -(float)i / 16.f); }

__device__ __forceinline__ float rstd_of(const float* parts, int row, int n, int dim) {
    float s = 0.f; const float* p = parts + (size_t)row * n;
    for (int i = 0; i < n; ++i) s += p[i];
    return 1.0f / sqrtf(s / (float)dim + EPS);
}

__device__ __forceinline__ void rope4(const P& p, int row, int i0, float (&v)[8]) {
    const float* t = (const float*)(p.ws + WS_ROPE) + (size_t)row * 32 + 2 * i0;
    const f32x4 a = *(const GAS f32x4*)t, b = *(const GAS f32x4*)(t + 4);
    const float cs[4] = {a.x, a.z, b.x, b.z}, sn[4] = {a.y, a.w, b.y, b.w};
#pragma unroll
    for (int q = 0; q < 4; ++q) { const float x1 = v[2 * q], x2 = v[2 * q + 1]; v[2 * q] = x1 * cs[q] - x2 * sn[q]; v[2 * q + 1] = x1 * sn[q] + x2 * cs[q]; }
}
__device__ __forceinline__ void prep_rope(const P& p, int idx) {
    const int row = idx >> 4, i = idx & 15; const float ang = (float)p.pos[row] * rope_freq(i); float sn, cs; sincosf(ang, &sn, &cs);
    float* t = (float*)(p.ws + WS_ROPE) + (size_t)idx * 2; t[0] = cs; t[1] = sn;
}
enum { EPI_IN = 0, EPI_QUP = 1, EPI_KVUP = 2, EPI_OUT = 3, EPI_UP = 4, EPI_DOWN = 5, EPI_IN8 = 6 };

template <int EPI> __device__ __forceinline__ float epi_row_scale(const P& p, int layer, int row) {
    const unsigned char* ws = p.ws;
    if (EPI == EPI_IN || EPI == EPI_IN8) return rstd_of((const float*)(ws + WS_RSA), row, 32, DM);
    if (EPI == EPI_QUP) return rstd_of((const float*)(ws + WS_RSCQ), row, 12, Q_LORA) * (0.10206207261596575f * LOG2E);
    if (EPI == EPI_KVUP) return rstd_of((const float*)(ws + WS_RSCKV), row, 8, KV_LORA);
    if (EPI == EPI_UP) return rstd_of((const float*)(ws + WS_RSB), row, 32, DM);
    return 1.f;
}

template <int EPI> __device__ __forceinline__ float epi8(const P& p, int layer, int row, int c0, float (&v)[8], float rs, int cs = -1) {
    if (cs < 0) cs = c0;
    unsigned char* ws = p.ws;
    const int b = row >> 12, s = row & (S - 1);
    float ss = 0.f;
    if (EPI == EPI_IN) {
#pragma unroll
        for (int j = 0; j < 8; ++j) v[j] *= rs;
        if (cs < 384) {
            u32x4 w = pk8(v); float r[8]; unpk8(w, r);
#pragma unroll
            for (int j = 0; j < 8; ++j) ss += r[j] * r[j];
            *(GAS u32x4*)((bf16_t*)(ws + WS_CQ) + (size_t)row * Q_LORA + c0) = w;
        } else if (cs < 416) {
            const int j0 = c0 - 384; rope4(p, row, j0 >> 1, v);
            *(GAS u32x4*)((bf16_t*)(ws + WS_KR) + kimg(b, s, j0, 4)) = pk8(v);
        } else if (cs < 448) {
            *(GAS u32x4*)((bf16_t*)(ws + WS_KI) + (size_t)row * 32 + (c0 - 416)) = pk8(v);
        } else if (cs < 480 && c0 < 456) {
            float* o = (float*)(ws + WS_WI) + (size_t)row * 8;
            *(GAS f32x4*)o = (f32x4){v[0], v[1], v[2], v[3]}; *(GAS f32x4*)(o + 4) = (f32x4){v[4], v[5], v[6], v[7]};
        } else if (cs < 512) {
        } else if (cs < 768) {
            u32x4 w = pk8(v); float r[8]; unpk8(w, r);
#pragma unroll
            for (int j = 0; j < 8; ++j) ss += r[j] * r[j];
            *(GAS u32x4*)((bf16_t*)(ws + WS_CKV) + (size_t)row * KV_LORA + (c0 - 512)) = w;
        } else if (cs < 1024) {
#pragma unroll
            for (int j = 0; j < 8; ++j) v[j] *= 0.125f * LOG2E;
            *(GAS u32x4*)((bf16_t*)(ws + WS_QB) + (size_t)row * 256 + (c0 - 768)) = pk8(v);
        } else if (cs < 1280) {
            *(GAS u32x4*)((bf16_t*)(ws + WS_QI) + (size_t)row * 256 + (c0 - 1024)) = pk8(v);
        } else if (cs < 1536) {
#pragma unroll
            for (int j = 0; j < 8; ++j) v[j] *= 0.17677669529663687f * LOG2E;
            *(GAS u32x4*)((bf16_t*)(ws + WS_QC) + (size_t)row * 256 + (c0 - 1280)) = pk8(v);
        } else if (cs < 1792) {
            const int j0 = c0 - 1536, h = j0 >> 6, cd = j0 & 63;
            *(GAS u32x4*)((bf16_t*)(ws + WS_KC) + kimg(b * 4 + h, s, cd, 8)) = pk8(v);
        } else if (cs < 2048) {
            const int j0 = c0 - 1792, h = j0 >> 6, d = j0 & 63;
            *(GAS u32x4*)((bf16_t*)(ws + WS_VC) + vimg(b * 4 + h, s, d)) = pk8(v);
        }
    } else if (EPI == EPI_IN8) {
#pragma unroll
        for (int j = 0; j < 8; ++j) v[j] *= rs;
        if (c0 < 2112) {
            *(GAS u32x4*)((bf16_t*)(ws + WS_KB) + kimg(b, s, c0 - 2048, 8)) = pk8(v);
        } else if (c0 < 2176) {
            *(GAS u32x4*)((bf16_t*)(ws + WS_VB) + vimg(b, s, c0 - 2112)) = pk8(v);
        }
    } else if (EPI == EPI_QUP) {
#pragma unroll
        for (int j = 0; j < 8; ++j) v[j] *= rs;
        const int j0 = c0 % 96;
        if (j0 >= 64) rope4(p, row, (j0 - 64) >> 1, v);
        *(GAS u32x4*)((bf16_t*)(ws + WS_QA) + (size_t)row * NQ_UP + c0) = pk8(v);
    } else if (EPI == EPI_KVUP) {
#pragma unroll
        for (int j = 0; j < 8; ++j) v[j] *= rs;
        const int h = c0 >> 7, j0 = c0 & 127;
        if (j0 < 64) *(GAS u32x4*)((bf16_t*)(ws + WS_KN) + kimg(b * 8 + h, s, j0, 8)) = pk8(v);
        else *(GAS u32x4*)((bf16_t*)(ws + WS_VA) + vimg(b * 8 + h, s, j0 - 64)) = pk8(v);
    } else if (EPI == EPI_OUT || EPI == EPI_DOWN) {
        bf16_t* xb = (bf16_t*)(ws + WS_XB) + (size_t)row * DM + c0;
        { float r[8]; unpk8(*(const GAS u32x4*)xb, r);
#pragma unroll
            for (int j = 0; j < 8; ++j) v[j] += r[j]; }
#pragma unroll
        for (int j = 0; j < 8; ++j) ss += v[j] * v[j];
        *(GAS u32x4*)xb = pk8(v);
    } else if (EPI == EPI_UP) {
#pragma unroll
        for (int j = 0; j < 8; ++j) { const float t = fmaxf(v[j] * rs, 0.f); v[j] = t * t; }
        *(GAS u32x4*)((bf16_t*)(ws + WS_U) + (size_t)row * DFF + c0) = pk8(v);
    }
    return ss;
}
template <int EPI> __device__ __forceinline__ void epi_part(const P& p, int row, int c32, float ss) {
    unsigned char* ws = p.ws;
    if (EPI == EPI_IN) {
        if (c32 < 12) ((GAS float*)(ws + WS_RSCQ))[(size_t)row * 12 + c32] = ss;
        else if (c32 >= 16 && c32 < 24) ((GAS float*)(ws + WS_RSCKV))[(size_t)row * 8 + (c32 - 16)] = ss;
    } else if (EPI == EPI_OUT) ((GAS float*)(ws + WS_RSB))[(size_t)row * 32 + c32] = ss;
    else if (EPI == EPI_DOWN) ((GAS float*)(ws + WS_RSA))[(size_t)row * 32 + c32] = ss;
}

enum { WM_IN = 0, WM_UQ = 1, WM_ID = 2 };
__device__ __forceinline__ int colmap(int mode, int np) {
    if (mode == WM_IN) {
        if (np < 384) return np;
        if (np < 416) { const int j = np - 384; return 640 + (j >> 1) + 16 * (j & 1); }
        if (np < 448) return 1312 + (np - 416);
        if (np < 456) return 1344 + (np - 448);
        if (np < 512) return -1;
        if (np < 768) return 384 + (np - 512);
        if (np < 1024) return 672 + (np - 768);
        if (np < 1280) return 1056 + (np - 1024);
        if (np < 1536) return 1352 + (np - 1280);
        if (np < 1792) return 1608 + (np - 1536);
        if (np < 2048) return 1864 + (np - 1792);
        if (np < 2112) return 928 + (np - 2048);
        if (np < 2176) return 992 + (np - 2112);
        return -1;
    }
    if (mode == WM_UQ) { const int h = np / 96, j = np % 96; if (j < 64) return np; const int jj = j - 64; return h * 96 + 64 + (jj >> 1) + 16 * (jj & 1); }
    return np;
}
struct WPrep { const float* w; const float* gain; bf16_t* out; int K, N, NP, mode; };
__device__ __forceinline__ void prep_w_load(const WPrep& a, int tile, int tid, float (&val)[8]) {
    const int ntn = a.NP / 64, kb = tile / ntn, nb = tile % ntn, k0 = kb * 64, n0 = nb * 64;
    const int tx = tid & 63, ty = tid >> 6;
    const int o = colmap(a.mode, n0 + tx);
#pragma unroll
    for (int i = 0; i < 8; ++i) { const int k = k0 + ty + 8 * i; val[i] = 0.f; if (o >= 0) { val[i] = a.w[(size_t)k * a.N + o]; if (a.gain) val[i] *= a.gain[k]; } }
}
__device__ __forceinline__ void prep_w_store(const WPrep& a, int tile, float* lds, int tid, const float (&val)[8]) {
    const int ntn = a.NP / 64, kb = tile / ntn, nb = tile % ntn, k0 = kb * 64, n0 = nb * 64;
    const int tx = tid & 63, ty = tid >> 6;
#pragma unroll
    for (int i = 0; i < 8; ++i) lds[(ty + 8 * i) * 65 + tx] = val[i];
    __syncthreads();
    { const int n = tid >> 3, kc = tid & 7; float v[8];
#pragma unroll
      for (int j = 0; j < 8; ++j) v[j] = lds[(8 * kc + j) * 65 + n];
      *(GAS u32x4*)(a.out + (size_t)(n0 + n) * a.K + k0 + 8 * kc) = pk8(v); }
    __syncthreads();
}
__device__ __forceinline__ WPrep wprep_of(const P& p, int idx) {
    const int l = idx / 6, w = idx % 6; unsigned char* ws = p.ws; WPrep a;
    switch (w) {
    case 0: a = WPrep{p.w_in + (size_t)l * DM * N_IN, p.norm_attn + l * DM, (bf16_t*)(ws + WS_WIN + l * SZ_WIN), DM, N_IN, N_INP, WM_IN}; break;
    case 1: a = WPrep{p.w_uq + (size_t)l * Q_LORA * NQ_UP, p.q_norm + l * Q_LORA, (bf16_t*)(ws + WS_WUQ + l * SZ_WUQ), Q_LORA, NQ_UP, NQ_UP, WM_UQ}; break;
    case 2: a = WPrep{p.w_ukv + (size_t)l * KV_LORA * NKV_UP, p.kv_norm + l * KV_LORA, (bf16_t*)(ws + WS_WUKV + l * SZ_WUKV), KV_LORA, NKV_UP, NKV_UP, WM_ID}; break;
    case 3: a = WPrep{p.w_out + (size_t)l * DM * DM, nullptr, (bf16_t*)(ws + WS_WOUT + l * SZ_WOUT), DM, DM, DM, WM_ID}; break;
    case 4: a = WPrep{p.w_up + (size_t)l * DM * DFF, p.norm_mlp + l * DM, (bf16_t*)(ws + WS_WUP + l * SZ_WUP), DM, DFF, DFF, WM_ID}; break;
    default: a = WPrep{p.w_down + (size_t)l * DFF * DM, nullptr, (bf16_t*)(ws + WS_WDN + l * SZ_WDN), DFF, DM, DM, WM_ID}; break;
    }
    return a;
}
__device__ __forceinline__ int wprep_tiles(int idx) {
    switch (idx % 6) { case 0: return (DM / 64) * (N_INP / 64); case 1: return (Q_LORA / 64) * (NQ_UP / 64); case 2: return (KV_LORA / 64) * (NKV_UP / 64);
                       case 3: return (DM / 64) * (DM / 64); case 4: return (DM / 64) * (DFF / 64); default: return (DFF / 64) * (DM / 64); }
}
__device__ __forceinline__ void prep_w_range(const P& p, int m0, int m1, int me, int nw, float* scr, int tid) {
    int total = 0;
    for (int i = m0; i < m1; ++i) total += wprep_tiles(i);
    int g = me, mi = m0, base = 0;
    while (mi < m1 && g >= base + wprep_tiles(mi)) { base += wprep_tiles(mi); ++mi; }
    float cur[8], nxt[8];
    if (g < total) { const WPrep w = wprep_of(p, mi); prep_w_load(w, g - base, tid, cur); }
    while (g < total) {
        const int g2 = g + nw; int mi2 = mi, base2 = base;
        while (mi2 < m1 && g2 >= base2 + wprep_tiles(mi2)) { base2 += wprep_tiles(mi2); ++mi2; }
        if (g2 < total) { const WPrep w2 = wprep_of(p, mi2); prep_w_load(w2, g2 - base2, tid, nxt); }
        { const WPrep w = wprep_of(p, mi); prep_w_store(w, g - base, scr, tid, cur); }
#pragma unroll
        for (int i = 0; i < 8; ++i) cur[i] = nxt[i];
        g = g2; mi = mi2; base = base2;
    }
}
__device__ __forceinline__ void prep_x_row(const P& p, int row, int lane) {
    const float* xr = p.x + (size_t)row * DM + lane * 16;
    float v[16];
#pragma unroll
    for (int j = 0; j < 4; ++j) { const f32x4 a = *(const GAS f32x4*)(xr + 4 * j); v[4 * j] = a.x; v[4 * j + 1] = a.y; v[4 * j + 2] = a.z; v[4 * j + 3] = a.w; }
    float ss = 0.f;
#pragma unroll
    for (int j = 0; j < 16; ++j) ss += v[j] * v[j];
    ss += __shfl_xor(ss, 1);
    if ((lane & 1) == 0) ((float*)(p.ws + WS_RSA))[(size_t)row * 32 + (lane >> 1)] = ss;
    bf16_t* xb = (bf16_t*)(p.ws + WS_XB) + (size_t)row * DM + lane * 16;
    float a8[8], b8[8];
#pragma unroll
    for (int j = 0; j < 8; ++j) { a8[j] = v[j]; b8[j] = v[8 + j]; }
    *(GAS u32x4*)xb = pk8(a8); *(GAS u32x4*)(xb + 8) = pk8(b8);
}
__device__ __forceinline__ void prep_lut(const P& p, int i) {
    if (i < 129 * 8) { const int rel = i >> 3, h = i & 7; ((float*)(p.ws + WS_MISC))[i] = p.rel_bias[t5_bucket(rel) * 8 + h] * LOG2E; }
}
namespace pg8 {
#define PG8_LAS __attribute__((address_space(3)))
constexpr int BM = 256, BK = 64, HALF = 128, HTB = HALF * BK * 2  , STAGE_BYTES = 8 * HTB, NXCD = 8, WGM = 8;

__host__ __device__ __forceinline__ int lds_byte(int r, int c) { const int st = (r >> 4) * 2 + (c >> 5), rr = r & 15, cc = c & 31, ob = rr * 64 + cc * 2; return st * 1024 + (ob ^ (((ob >> 9) & 1) << 5)); }
__host__ __device__ __forceinline__ void stage_rc(int b, int& R, int& C) { const int st = b / 1024, sb = b % 1024, swz = sb ^ (((sb >> 9) & 1) << 5); R = (st >> 1) * 16 + swz / 64; C = (st & 1) * 32 + (swz % 64) / 2; }
__host__ __device__ __forceinline__ int perm32(int rho) { const int n = rho >> 4, i = rho & 15; return 8 * (i >> 2) + 4 * n + (i & 3); }

struct Unit { int pm, pn; };
struct Gemm { const bf16_t* A; const bf16_t* Bt; int M, N, K; };

struct StaticOrder {
    int nM, nN, nwg, G, c;
    __host__ __device__ void init(int M, int N, int G_, int c_) { nM = M / BM; nN = N / BM; nwg = nM * nN; G = G_; c = c_; }
    __host__ __device__ bool next(int i, Unit& u) const {
        const long L = (long)i * G + c; if (L >= nwg) return false;
        int wgid = (int)L; { const int q = nwg / NXCD, r = nwg % NXCD, xcd = wgid % NXCD, off = wgid / NXCD; wgid = (xcd < r ? xcd * (q + 1) : r * (q + 1) + (xcd - r) * q) + off; }
        const int nig = WGM * nN, gid = wgid / nig, fm = gid * WGM, gsz = (nM - fm) < WGM ? (nM - fm) : WGM;
        u.pm = fm + ((wgid % nig) % gsz); u.pn = (wgid % nig) / gsz; return true;
    }
    __device__ __forceinline__ void a_ready(const Unit&) const {}
    __device__ __forceinline__ void done(const Unit&) const {}
};
template <class Epi, class Sched, bool ALIGN_EPI = false, bool SP2 = false>
__device__ __forceinline__ void gemm_phase(PG8_LAS unsigned char* lds, const Gemm g, const Sched& S, const Epi& E, int wave_id) {
    const int tid_ = phase_tid(wave_id);
    const int tid = tid_, wid = __builtin_amdgcn_readfirstlane(tid >> 6), lane = tid & 63, wr = wid >> 2, wc = wid & 3, fr = lane & 15, fq = lane >> 4;
    const int K = g.K, nt = K / BK;
    unsigned voffA[2], voffB[2];
#pragma unroll
    for (int i = 0; i < 2; ++i) { int R, C; stage_rc(tid * 16 + i * 8192, R, C); const int Rb = Epi::PERM ? ((R & ~31) + perm32(R & 31)) : R;
        voffA[i] = (unsigned)(R * K + C) * 2u; voffB[i] = (unsigned)(Rb * K + C) * 2u; }
    const size_t kstep = (size_t)(BK * 2);
    const size_t hstep = (size_t)HALF * K * 2;
    const size_t tstep = 2 * hstep;
    const unsigned ldsw = (unsigned)wid * 1024u;
    const int aoff = lds_byte(wr * 64 + fr, fq * 8), boff = lds_byte(wc * 32 + fr, fq * 8);
#define PG8_SA(b, h) (((b) * 2 + (h)) * HTB)
#define PG8_SB(b, h) ((4 + (b) * 2 + (h)) * HTB)
#define PG8_STAGE(bufoff, gbase, voff) do { _Pragma("unroll") for (int _i = 0; _i < 2; ++_i) \
        __builtin_amdgcn_global_load_lds((const unsigned*)((const char*)(gbase) + (voff)[_i]), (PG8_LAS unsigned*)(lds + (bufoff) + ldsw + _i * 8192), 16, 0, 0); } while (0)
#define PG8_LDA(dst, b, h) do { _Pragma("unroll") for (int m = 0; m < 4; ++m) _Pragma("unroll") for (int k = 0; k < 2; ++k) dst[m][k] = *(const PG8_LAS bf16x8*)(lds + PG8_SA(b, h) + aoff + m * 2048 + k * 1024); } while (0)
#define PG8_LDB(dst, b, h) do { _Pragma("unroll") for (int n = 0; n < 2; ++n) _Pragma("unroll") for (int k = 0; k < 2; ++k) dst[n][k] = *(const PG8_LAS bf16x8*)(lds + PG8_SB(b, h) + boff + n * 2048 + k * 1024); } while (0)
#define PG8_MMA(ai, bj, At, Bt) do { __builtin_amdgcn_s_setprio(1); _Pragma("unroll") for (int m = 0; m < 4; ++m) _Pragma("unroll") for (int n = 0; n < 2; ++n) _Pragma("unroll") for (int k = 0; k < 2; ++k) \
        acc[ai][bj][m][n] = __builtin_amdgcn_mfma_f32_16x16x32_bf16(Bt[n][k], At[m][k], acc[ai][bj][m][n], 0, 0, 0); __builtin_amdgcn_s_setprio(0); } while (0)
#define PG8_WAIT_V(n) asm volatile("s_waitcnt vmcnt(" #n ")" ::: "memory")
#define PG8_WAIT_L(n) asm volatile("s_waitcnt lgkmcnt(" #n ")" ::: "memory")
#define PG8_BAR __builtin_amdgcn_s_barrier()
#define PG8_SCHED __builtin_amdgcn_sched_barrier(0)
    Unit cur, nxt; int ui = 0;
    if (!S.next(0, cur)) return;
    f32x4 acc[2][2][4][2];
#pragma unroll
    for (int a = 0; a < 2; ++a)
#pragma unroll
        for (int b = 0; b < 2; ++b)
#pragma unroll
            for (int m = 0; m < 4; ++m)
#pragma unroll
                for (int n = 0; n < 2; ++n) acc[a][b][m][n] = (f32x4){0.f, 0.f, 0.f, 0.f};
    bf16x8 At[4][2], B0[2][2], B1[2][2];
    const char* cA = (const char*)g.A + (size_t)cur.pm * tstep; const char* cB = (const char*)g.Bt + (size_t)cur.pn * tstep;
    S.a_ready(cur);
    if constexpr (SP2) {
        PG8_STAGE(PG8_SB(0, 0), cB, voffB); PG8_STAGE(PG8_SB(0, 1), cB + hstep, voffB); PG8_STAGE(PG8_SA(0, 0), cA, voffA); PG8_STAGE(PG8_SA(0, 1), cA + hstep, voffA);
        if (wr == 1) PG8_BAR;
        PG8_WAIT_V(2); PG8_BAR;
        PG8_STAGE(PG8_SB(1, 0), cB + kstep, voffB); PG8_STAGE(PG8_SA(1, 0), cA + kstep, voffA); PG8_STAGE(PG8_SB(1, 1), cB + hstep + kstep, voffB);
        PG8_WAIT_V(6); PG8_BAR;
    } else {
        PG8_STAGE(PG8_SB(0, 0), cB, voffB); PG8_STAGE(PG8_SA(0, 0), cA, voffA); PG8_STAGE(PG8_SB(0, 1), cB + hstep, voffB); PG8_STAGE(PG8_SA(0, 1), cA + hstep, voffA);
        if (wr == 1) PG8_BAR;
        PG8_WAIT_V(4); PG8_BAR;
        PG8_STAGE(PG8_SB(1, 0), cB + kstep, voffB); PG8_STAGE(PG8_SA(1, 0), cA + kstep, voffA); PG8_STAGE(PG8_SB(1, 1), cB + hstep + kstep, voffB);
        PG8_WAIT_V(6); PG8_BAR;
    }
    for (;;) {
        const bool has_next = S.next(ui + 1, nxt);
        const char* nA = has_next ? (const char*)g.A + (size_t)nxt.pm * tstep : cA; const char* nB = has_next ? (const char*)g.Bt + (size_t)nxt.pn * tstep : cB;
#pragma unroll 1
        for (int t = 0; t < nt; t += 2) {
            const bool last = (t == nt - 2);
            const char* a1 = cA + (size_t)(t + 1) * kstep;
            const char* a2 = last ? nA : cA + (size_t)(t + 2) * kstep; const char* b2 = last ? nB : cB + (size_t)(t + 2) * kstep;
            const char* a3 = a2 + kstep; const char* b3 = b2 + kstep;
            if (last && has_next) S.a_ready(nxt);
            if constexpr (SP2) {
            PG8_LDB(B0, 0, 0); PG8_LDB(B1, 0, 1); PG8_SCHED; PG8_LDA(At, 0, 0); PG8_STAGE(PG8_SA(1, 1), a1 + hstep, voffA);
            PG8_WAIT_V(8); PG8_WAIT_L(0); PG8_BAR; PG8_MMA(0, 0, At, B0); PG8_MMA(0, 1, At, B1); PG8_BAR; PG8_SCHED;
            PG8_LDA(At, 0, 1); PG8_STAGE(PG8_SB(0, 0), b2, voffB); PG8_STAGE(PG8_SB(0, 1), b2 + hstep, voffB); PG8_STAGE(PG8_SA(0, 0), a2, voffA);
            PG8_WAIT_V(8); PG8_WAIT_L(0); PG8_BAR; PG8_MMA(1, 0, At, B0); PG8_MMA(1, 1, At, B1); PG8_BAR; PG8_SCHED;
            PG8_LDB(B0, 1, 0); PG8_LDB(B1, 1, 1); PG8_SCHED; PG8_LDA(At, 1, 0); PG8_STAGE(PG8_SA(0, 1), a2 + hstep, voffA);
            PG8_WAIT_V(8); PG8_WAIT_L(0); PG8_BAR; PG8_MMA(0, 0, At, B0); PG8_MMA(0, 1, At, B1); PG8_BAR; PG8_SCHED;
            PG8_LDA(At, 1, 1); PG8_STAGE(PG8_SB(1, 0), b3, voffB); PG8_STAGE(PG8_SB(1, 1), b3 + hstep, voffB); PG8_STAGE(PG8_SA(1, 0), a3, voffA);
            PG8_WAIT_V(8); PG8_WAIT_L(0); PG8_BAR; PG8_MMA(1, 0, At, B0); PG8_MMA(1, 1, At, B1); PG8_BAR; PG8_SCHED;
            } else {
            PG8_LDB(B0, 0, 0); PG8_SCHED; PG8_LDA(At, 0, 0); PG8_STAGE(PG8_SA(1, 1), a1 + hstep, voffA);
            PG8_WAIT_L(8); PG8_BAR; PG8_WAIT_L(0); PG8_MMA(0, 0, At, B0); PG8_BAR; PG8_SCHED;
            PG8_LDB(B1, 0, 1); PG8_STAGE(PG8_SB(0, 0), b2, voffB);
            PG8_BAR; PG8_WAIT_L(0); PG8_MMA(0, 1, At, B1); PG8_BAR;
            PG8_LDA(At, 0, 1); PG8_STAGE(PG8_SA(0, 0), a2, voffA);
            PG8_BAR; PG8_WAIT_L(0); PG8_MMA(1, 0, At, B0); PG8_BAR; PG8_SCHED;
            PG8_STAGE(PG8_SB(0, 1), b2 + hstep, voffB);
            PG8_WAIT_V(6); PG8_BAR; PG8_MMA(1, 1, At, B1); PG8_BAR;
            PG8_LDB(B0, 1, 0); PG8_SCHED; PG8_LDA(At, 1, 0); PG8_STAGE(PG8_SA(0, 1), a2 + hstep, voffA);
            PG8_WAIT_L(8); PG8_BAR; PG8_WAIT_L(0); PG8_MMA(0, 0, At, B0); PG8_BAR; PG8_SCHED;
            PG8_LDB(B1, 1, 1); PG8_STAGE(PG8_SB(1, 0), b3, voffB);
            PG8_BAR; PG8_WAIT_L(0); PG8_MMA(0, 1, At, B1); PG8_BAR;
            PG8_LDA(At, 1, 1); PG8_STAGE(PG8_SA(1, 0), a3, voffA);
            PG8_BAR; PG8_WAIT_L(0); PG8_MMA(1, 0, At, B0); PG8_BAR; PG8_SCHED;
            PG8_STAGE(PG8_SB(1, 1), b3 + hstep, voffB);
            PG8_WAIT_V(6); PG8_BAR; PG8_MMA(1, 1, At, B1); PG8_BAR;
            }
        }
        if constexpr (ALIGN_EPI) { if (wr == 0) PG8_BAR; }
        if constexpr (!Epi::AFTER_DRAIN) { E(acc, cur, wr, wc, fr, fq); S.done(cur); }
        if (!has_next) break;
#pragma unroll
        for (int a = 0; a < 2; ++a)
#pragma unroll
            for (int b = 0; b < 2; ++b)
#pragma unroll
                for (int m = 0; m < 4; ++m)
#pragma unroll
                    for (int n = 0; n < 2; ++n) acc[a][b][m][n] = (f32x4){0.f, 0.f, 0.f, 0.f};
        cur = nxt; cA = nA; cB = nB; ++ui;
        if constexpr (ALIGN_EPI) { if (wr == 1) PG8_BAR; }
    }
    PG8_WAIT_V(0);
    if constexpr (!ALIGN_EPI) { if (wr == 0) PG8_BAR; }
    PG8_BAR;
    if constexpr (Epi::AFTER_DRAIN) { E.fused(acc, cur, wr, wc, fr, fq, lds, wid, lane); S.done(cur); }
#undef PG8_SA
#undef PG8_SB
#undef PG8_STAGE
#undef PG8_LDA
#undef PG8_LDB
#undef PG8_MMA
#undef PG8_WAIT_V
#undef PG8_WAIT_L
#undef PG8_BAR
#undef PG8_SCHED
}
}
#define LAS __attribute__((address_space(3)))
#define XB_TMO      128
#define XB_XCNT(j)  (256  + 64 * (j))
#define XB_XSUB(j)  (1280 + 64 * (j))
#define XB_XGEN(j)  (2304 + 64 * (j))
#define XB_TOP      3328
#define XB_TOPGEN   3392
#define XCD_BAR_WORDS 3456
#define XB_SPIN_CAP (1u << 18)

__device__ __forceinline__ unsigned xb_ld(unsigned* p)              { return __hip_atomic_load(p, __ATOMIC_RELAXED, __HIP_MEMORY_SCOPE_AGENT); }
__device__ __forceinline__ unsigned xb_add(unsigned* p, unsigned v) { return __hip_atomic_fetch_add(p, v, __ATOMIC_RELAXED, __HIP_MEMORY_SCOPE_AGENT); }
__device__ __forceinline__ unsigned xb_xcc_id() { return (unsigned)__builtin_amdgcn_s_getreg((3 << 11) | 20) & 0xFu; }
#define XB_SPIN(cond, bar) do { unsigned _sp = 0; while (cond) { __builtin_amdgcn_s_sleep(1); \
    if ((++_sp & 255u) == 0u) { if (xb_ld(&(bar)[XB_TMO])) break; if (_sp > XB_SPIN_CAP) { atomicAdd(&(bar)[XB_TMO], 1u); break; } } } } while (0)

struct XcdBarrier {
    unsigned* bar; unsigned x;
    volatile LAS unsigned* st;
};

__device__ __forceinline__ XcdBarrier xcd_barrier_post(unsigned* bar, volatile LAS unsigned* st, int tid) {
    XcdBarrier b; b.bar = bar; b.x = xb_xcc_id(); b.st = st;
    if (tid == 0) (void)xb_add(&bar[XB_XCNT(b.x)], 1u);
    return b;
}
__device__ __forceinline__ void xcd_barrier_complete(unsigned* bar, unsigned x, unsigned& nloc, unsigned& nx) {
    const unsigned G = gridDim.x * gridDim.y * gridDim.z;
    unsigned sum, cnt, mine, sp = 0u;
    for (;;) {
        sum = 0u; cnt = 0u; mine = 0u;
#pragma unroll
        for (unsigned j = 0; j < 16; ++j) { const unsigned c = xb_ld(&bar[XB_XCNT(j)]); sum += c; cnt += (c > 0u) ? 1u : 0u; mine = (j == x) ? c : mine; }
        if (sum == G) break;
        __builtin_amdgcn_s_sleep(1);
        if ((++sp & 255u) == 0u) { if (xb_ld(&bar[XB_TMO])) break; if (sp > XB_SPIN_CAP) { atomicAdd(&bar[XB_TMO], 1u); break; } }
    }
    nloc = mine > 0u ? mine : 1u; nx = cnt > 0u ? cnt : 1u;
}

__device__ __forceinline__ void xcd_barrier(const XcdBarrier& b, int tid) {
    asm volatile("s_waitcnt vmcnt(0)" ::: "memory");
    __syncthreads();
    if (tid == 0) {
        unsigned* bar = b.bar; unsigned bx = b.x;
        asm volatile("" : "+s"(bar), "+s"(bx));
        __builtin_amdgcn_s_waitcnt(0);
        unsigned nloc = b.st[0], nx = b.st[1];
        if (nloc == 0u) { xcd_barrier_complete(bar, bx, nloc, nx); b.st[0] = nloc; b.st[1] = nx; }
        const unsigned old = xb_add(&bar[XB_XSUB(bx)], 1u);
        const unsigned gen = old / nloc;
        if (old + 1u == (gen + 1u) * nloc) {
            __builtin_amdgcn_fence(__ATOMIC_RELEASE, "agent");
            asm volatile("s_waitcnt vmcnt(0)" ::: "memory");
            const unsigned og = xb_add(&bar[XB_TOP], 1u);
            const unsigned tg = og / nx;
            if (og + 1u == (tg + 1u) * nx) xb_add(&bar[XB_TOPGEN], 1u);
            else XB_SPIN(xb_ld(&bar[XB_TOPGEN]) == tg, bar);
            __builtin_amdgcn_fence(__ATOMIC_ACQUIRE, "agent");
            xb_add(&bar[XB_XGEN(bx)], 1u);
            asm volatile("s_waitcnt vmcnt(0)" ::: "memory");
        } else {
            XB_SPIN(xb_ld(&bar[XB_XGEN(bx)]) == gen, bar);
            __builtin_amdgcn_fence(__ATOMIC_ACQUIRE, "agent");
            asm volatile("s_waitcnt vmcnt(0)" ::: "memory");
        }
    }
    __syncthreads();
}
constexpr int NWAVES = 8;
constexpr int RING_BYTES = 131072;
constexpr int LDSCTL_OFF = RING_BYTES + 8192 + 512, MISC_OFF = LDSCTL_OFF;
constexpr int LDS_BYTES = 147456;
constexpr size_t CTL_ZERO_BYTES = 1 * MiB;
constexpr int CW_BAR = 4096;
constexpr int CW_AFF = 12288;
constexpr int CW_WQ = 16384;
constexpr int CW_FIN = 20480;
constexpr size_t MISC_FINX = 65536;

template <int EPI> __device__ __forceinline__ float fast_row_scale(const P& p, int row, int fq) {
    const unsigned char* ws = p.ws; float s = 0.f;
    if (EPI == EPI_IN || EPI == EPI_IN8 || EPI == EPI_UP) { const float* q = (const float*)(ws + (EPI == EPI_UP ? WS_RSB : WS_RSA)) + (size_t)row * 32 + 8 * fq;
        const f32x4 a = *(const GAS f32x4*)q, b = *(const GAS f32x4*)(q + 4); s = ((a.x + a.y) + (a.z + a.w)) + ((b.x + b.y) + (b.z + b.w)); }
    else if (EPI == EPI_QUP) { if (fq < 3) { const f32x4 a = *(const GAS f32x4*)((const float*)(ws + WS_RSCQ) + (size_t)row * 12 + 4 * fq); s = (a.x + a.y) + (a.z + a.w); } }
    else if (EPI == EPI_KVUP) { const GAS float* q = (const GAS float*)(ws + WS_RSCKV) + (size_t)row * 8 + 2 * fq; s = q[0] + q[1]; }
    else return 1.f;
    s += __shfl_xor(s, 16); s += __shfl_xor(s, 32);
    if (EPI == EPI_IN || EPI == EPI_IN8 || EPI == EPI_UP) return 1.0f / sqrtf(s / (float)DM + EPS);
    if (EPI == EPI_QUP) return 1.0f / sqrtf(s / (float)Q_LORA + EPS) * (0.10206207261596575f * LOG2E);
    return 1.0f / sqrtf(s / (float)KV_LORA + EPS);
}
template <int EPI> struct EpiX {
    static constexpr bool PERM = true, AFTER_DRAIN = false;
    P p; int layer; int col_off;
    __device__ __forceinline__ void operator()(const f32x4 (&acc)[2][2][4][2], const pg8::Unit& u, int wr, int wc, int fr, int fq) const {
        P p = this->p; asm volatile("" : "+s"(p.ws));
        int upm = u.pm, upn = u.pn; asm volatile("" : "+s"(upm), "+s"(upn));
#pragma unroll
        for (int ai = 0; ai < 2; ++ai)
#pragma unroll
            for (int m = 0; m < 4; ++m) {
                const int row = upm * 256 + ai * 128 + wr * 64 + m * 16 + fr;
                const float rs = fast_row_scale<EPI>(p, row, fq);
#pragma unroll
                for (int bj = 0; bj < 2; ++bj) {
                    const int c0 = col_off + upn * 256 + bj * 128 + wc * 32 + 8 * fq;
                    float v[8] = {acc[ai][bj][m][0][0], acc[ai][bj][m][0][1], acc[ai][bj][m][0][2], acc[ai][bj][m][0][3], acc[ai][bj][m][1][0], acc[ai][bj][m][1][1], acc[ai][bj][m][1][2], acc[ai][bj][m][1][3]};
                    const int cs = __builtin_amdgcn_readfirstlane(c0 - 8 * fq);
                    float ss = epi8<EPI>(p, layer, row, c0, v, rs, cs);
                    if (EPI == EPI_IN || EPI == EPI_OUT || EPI == EPI_DOWN) {
                        ss += __shfl_xor(ss, 16); ss += __shfl_xor(ss, 32);
                        if (fq == 0) epi_part<EPI>(p, row, c0 >> 5, ss);
                    }
                }
            }
    }
};
struct EpiNone {
    static constexpr bool PERM = true, AFTER_DRAIN = false;
    P p;
    __device__ __forceinline__ void operator()(const f32x4 (&acc)[2][2][4][2], const pg8::Unit& u, int wr, int wc, int fr, int fq) const {
        int upm = u.pm, upn = u.pn; asm volatile("" : "+s"(upm), "+s"(upn));
#pragma unroll
        for (int ai = 0; ai < 2; ++ai)
#pragma unroll
            for (int m = 0; m < 4; ++m)
#pragma unroll
                for (int bj = 0; bj < 2; ++bj) { const int row = upm * 256 + ai * 128 + wr * 64 + m * 16 + fr, c0 = (upn & 3) * 256 + bj * 128 + wc * 32 + 8 * fq;
                    float v[8] = {acc[ai][bj][m][0][0], acc[ai][bj][m][0][1], acc[ai][bj][m][0][2], acc[ai][bj][m][0][3], acc[ai][bj][m][1][0], acc[ai][bj][m][1][1], acc[ai][bj][m][1][2], acc[ai][bj][m][1][3]};
                    *(GAS u32x4*)((bf16_t*)(p.ws + WS_MIX) + (size_t)row * DM + c0) = pk8(v); }
    }
};
__device__ __forceinline__ void run_gemm_none(PG8_LAS unsigned char* lds, const P& p, size_t a_off, size_t b_off, int M, int N, int K, int wave) {
    pg8::Gemm g{(const bf16_t*)(p.ws + a_off), (const bf16_t*)(p.ws + b_off), M, N, K};
    pg8::StaticOrder So; So.init(M, N, (int)gridDim.x, (int)blockIdx.x);
    EpiNone E{p};
    pg8::gemm_phase<EpiNone, pg8::StaticOrder, true, true>(lds, g, So, E, wave);
}
struct EpiFinal {
    static constexpr bool PERM = true, AFTER_DRAIN = true;
    P p;
    __device__ __forceinline__ void operator()(const f32x4 (&)[2][2][4][2], const pg8::Unit&, int, int, int, int) const {}
    __device__ __forceinline__ void fused(const f32x4 (&acc_)[2][2][4][2], const pg8::Unit& u, int wr, int wc, int fr, int fq, PG8_LAS unsigned char* lds, int wid, int lane) const {
        f32x4 (&acc)[2][2][4][2] = const_cast<f32x4 (&)[2][2][4][2]>(acc_);
        P p = this->p; asm volatile("" : "+s"(p.ws));
        int upm = u.pm, upn = u.pn; asm volatile("" : "+s"(upm), "+s"(upn));
        PG8_LAS float* part = (PG8_LAS float*)lds;
        PG8_LAS float* rs = part + 1024;
        const int tid = wid * 64 + lane;
#pragma unroll
        for (int ai = 0; ai < 2; ++ai)
#pragma unroll
            for (int m = 0; m < 4; ++m) {
                const int rl = ai * 128 + wr * 64 + m * 16 + fr, row = upm * 256 + rl; float ss = 0.f;
#pragma unroll
                for (int bj = 0; bj < 2; ++bj) { const int c0 = upn * 256 + bj * 128 + wc * 32 + 8 * fq; float r[8];
                    unpk8(*(const GAS u32x4*)((const bf16_t*)(p.ws + WS_XB) + (size_t)row * DM + c0), r);
#pragma unroll
                    for (int j = 0; j < 4; ++j) { acc[ai][bj][m][0][j] += r[j]; acc[ai][bj][m][1][j] += r[4 + j]; ss += acc[ai][bj][m][0][j] * acc[ai][bj][m][0][j] + acc[ai][bj][m][1][j] * acc[ai][bj][m][1][j]; } }
                ss += __shfl_xor(ss, 16); ss += __shfl_xor(ss, 32);
                if (fq == 0) part[rl * 4 + wc] = ss;
            }
        __syncthreads();
        GAS unsigned* X = (GAS unsigned*)(p.ws + WS_MISC + MISC_FINX) + (size_t)upm * 1024;
        if (tid < 256) { const float s = (part[tid * 4] + part[tid * 4 + 1]) + (part[tid * 4 + 2] + part[tid * 4 + 3]);
            __hip_atomic_store(X + upn * 256 + tid, __float_as_uint(s), __ATOMIC_RELAXED, __HIP_MEMORY_SCOPE_AGENT); }
        asm volatile("s_waitcnt vmcnt(0)" ::: "memory");
        __syncthreads();
        if (tid == 0) { GAS unsigned* cnt = (GAS unsigned*)(p.ws + WS_CTL) + CW_FIN + 64 * upm;
            __hip_atomic_fetch_add(cnt, 1u, __ATOMIC_RELAXED, __HIP_MEMORY_SCOPE_AGENT);
            unsigned sp = 0; while (__hip_atomic_load(cnt, __ATOMIC_RELAXED, __HIP_MEMORY_SCOPE_AGENT) < 4u && ++sp < (1u << 22)) __builtin_amdgcn_s_sleep(1); }
        __syncthreads();
        if (tid < 256) { float s = 0.f;
#pragma unroll
            for (int o = 0; o < 4; ++o) s += __uint_as_float(__hip_atomic_load(X + o * 256 + tid, __ATOMIC_RELAXED, __HIP_MEMORY_SCOPE_AGENT));
            rs[tid] = 1.0f / sqrtf(s / (float)DM + EPS); }
        __syncthreads();
#pragma unroll
        for (int ai = 0; ai < 2; ++ai)
#pragma unroll
            for (int m = 0; m < 4; ++m) {
                const int rl = ai * 128 + wr * 64 + m * 16 + fr, row = upm * 256 + rl; const float rr = rs[rl];
#pragma unroll
                for (int bj = 0; bj < 2; ++bj) { const int c0 = upn * 256 + bj * 128 + wc * 32 + 8 * fq;
                    const f32x4 g0 = *(const GAS f32x4*)(p.norm_final + c0), g1 = *(const GAS f32x4*)(p.norm_final + c0 + 4);
                    GAS f32x4* o = (GAS f32x4*)(p.out + (size_t)row * DM + c0);
                    o[0] = (f32x4){acc[ai][bj][m][0][0] * rr * g0.x, acc[ai][bj][m][0][1] * rr * g0.y, acc[ai][bj][m][0][2] * rr * g0.z, acc[ai][bj][m][0][3] * rr * g0.w};
                    o[1] = (f32x4){acc[ai][bj][m][1][0] * rr * g1.x, acc[ai][bj][m][1][1] * rr * g1.y, acc[ai][bj][m][1][2] * rr * g1.z, acc[ai][bj][m][1][3] * rr * g1.w}; }
            }
    }
};
__device__ __forceinline__ void run_gemm_final(PG8_LAS unsigned char* lds, const P& p, size_t a_off, size_t b_off, int wave) {
    pg8::Gemm g{(const bf16_t*)(p.ws + a_off), (const bf16_t*)(p.ws + b_off), T, DM, DFF};
    pg8::StaticOrder So; So.init(T, DM, (int)gridDim.x, (int)blockIdx.x);
    EpiFinal E{p};
    pg8::gemm_phase<EpiFinal, pg8::StaticOrder, true, true>(lds, g, So, E, wave);
}
template <int EPI> __device__ __forceinline__ void run_gemm(PG8_LAS unsigned char* lds, const P& p, int layer, size_t a_off, size_t b_off, int M, int N, int K, int wave, int col_off = 0) {
    pg8::Gemm g{(const bf16_t*)(p.ws + a_off), (const bf16_t*)(p.ws + b_off), M, N, K};
    pg8::StaticOrder So; So.init(M, N, (int)gridDim.x, (int)blockIdx.x);
    EpiX<EPI> E{p, layer, col_off};
    pg8::gemm_phase<EpiX<EPI>, pg8::StaticOrder, true, true>(lds, g, So, E, wave);
}

struct OneUnit {
    pg8::Unit u;
    __device__ __forceinline__ bool next(int i, pg8::Unit& o) const { if (i) return false; o = u; return true; }
    __device__ __forceinline__ void a_ready(const pg8::Unit&) const {}
    __device__ __forceinline__ void done(const pg8::Unit&) const {}
};
__device__ __forceinline__ void run_gemm_unit(PG8_LAS unsigned char* lds, const P& p, int layer, int kind, int pm, int pn, int wave) {
    OneUnit So; So.u.pm = pm; So.u.pn = pn;
    if (kind == 0) { pg8::Gemm g{(const bf16_t*)(p.ws + WS_CQ), (const bf16_t*)(p.ws + WS_WUQ + layer * SZ_WUQ), T, NQ_UP, Q_LORA};
        EpiX<EPI_QUP> E{p, layer, 0}; pg8::gemm_phase<EpiX<EPI_QUP>, OneUnit, true, true>(lds, g, So, E, wave); }
    else if (kind == 1) { pg8::Gemm g{(const bf16_t*)(p.ws + WS_CKV), (const bf16_t*)(p.ws + WS_WUKV + layer * SZ_WUKV), T, NKV_UP, KV_LORA};
        EpiX<EPI_KVUP> E{p, layer, 0}; pg8::gemm_phase<EpiX<EPI_KVUP>, OneUnit, true, true>(lds, g, So, E, wave); }
    else { pg8::Gemm g{(const bf16_t*)(p.ws + WS_XB), (const bf16_t*)(p.ws + WS_WIN + layer * SZ_WIN + (size_t)2048 * DM * 2), T, 256, DM};
        EpiX<EPI_IN8> E{p, layer, 2048}; pg8::gemm_phase<EpiX<EPI_IN8>, OneUnit, true, true>(lds, g, So, E, wave); }
}
typedef short s16x4 __attribute__((ext_vector_type(4)));
typedef short v4i16_t __attribute__((ext_vector_type(4)));
typedef LAS const char* lds_cptr;
#define MFMA32(a, b, c) __builtin_amdgcn_mfma_f32_32x32x16_bf16(a, b, c, 0, 0, 0)
#define MFMA16(a, b, c) __builtin_amdgcn_mfma_f32_16x16x32_bf16(a, b, c, 0, 0, 0)
__device__ __forceinline__ int crow(int r, int hi) { return (r & 3) + 8 * (r >> 2) + 4 * hi; }
__device__ __forceinline__ unsigned cvtpk(float lo, float hi) { unsigned r; asm("v_cvt_pk_bf16_f32 %0, %1, %2" : "=v"(r) : "v"(lo), "v"(hi)); return r; }
__device__ __forceinline__ void glds16(const void* g, unsigned lds_base) {
    unsigned sv; asm volatile("s_mov_b32 %0, m0\n\ts_mov_b32 m0, %2\n\ts_nop 0\n\tglobal_load_lds_dwordx4 %1, off\n\ts_mov_b32 m0, %0" : "=&s"(sv) : "v"(g), "s"(lds_base) : "memory"); }
__device__ __forceinline__ s16x4 vtr(lds_cptr p) { return __builtin_bit_cast(s16x4, __builtin_amdgcn_ds_read_tr16_b64_v4i16((LAS v4i16_t*)p)); }
__device__ __forceinline__ float xhalf_max(float m) { auto rr = __builtin_amdgcn_permlane32_swap(__float_as_uint(m), __float_as_uint(m), false, false); return fmaxf(__uint_as_float(rr[0]), __uint_as_float(rr[1])); }
__device__ __forceinline__ float xhalf_sum(float m) { auto rr = __builtin_amdgcn_permlane32_swap(__float_as_uint(m), __float_as_uint(m), false, false); return __uint_as_float(rr[0]) + __uint_as_float(rr[1]); }
__device__ __forceinline__ float rowmax32(const f32x16& a, const f32x16& b) {
    float m = fmaxf(a[0], b[0]);
#pragma unroll
    for (int r = 1; r < 16; ++r) m = fmaxf(m, fmaxf(a[r], b[r]));
    return xhalf_max(m); }
#define WAIT_BAR0() asm volatile("s_waitcnt vmcnt(0) lgkmcnt(0)\n\ts_barrier" ::: "memory")

constexpr int AT_KOFF = 0, AT_VOFF = 2 * 12288, AT_LUT = AT_VOFF + 2 * 8192, AT_END = AT_LUT + 1024;
constexpr size_t MISC_PMIN32 = 8192, MISC_PMAX64 = 12288;
constexpr float NEG_INF = -__builtin_huge_valf();

template <int VAR> __device__ __forceinline__ void attn_unit(const P& p, int layer, int b, int h, int qb, LAS unsigned char* lds, int wave) {
    constexpr int NCH = (VAR == 0) ? 12 : 8, ND0 = (VAR == 0) ? 6 : (VAR == 2 ? 4 : 2), NC = (VAR == 1) ? 2 : 1;
    constexpr int KSLOT = 12288, VSLOT = 8192;
    const int tid = phase_tid(wave), lane = tid & 63, r32 = lane & 31, hi = lane >> 5, wid = wave;
    const int q0 = qb * 256, NT = 4 * (qb + 1);
    const int qidx = q0 + wid * 32 + r32, qrow = b * S + qidx;
    const unsigned char* ws = p.ws; asm volatile("" : "+s"(ws));
    const unsigned lds0 = (unsigned)(uintptr_t)lds;
    const char* ksrc; const char* ksrc2 = nullptr; const char* vsrc; size_t kstep2 = 0;
    if (VAR == 0) { ksrc = (const char*)(ws + WS_KN) + ((size_t)(b * 8 + h) * NT64 * 8 + wid) * 1024 + lane * 16;
                    ksrc2 = (const char*)(ws + WS_KR) + ((size_t)b * NT64 * 4 + (wid & 3)) * 1024 + lane * 16; kstep2 = 4096;
                    vsrc = (const char*)(ws + WS_VA) + (size_t)(b * 8 + h) * NT64 * 8192 + wid * 1024 + lane * 16; }
    else if (VAR == 1) { ksrc = (const char*)(ws + WS_KC) + ((size_t)(b * 4 + h) * NT64 * 8 + wid) * 1024 + lane * 16;
                         vsrc = (const char*)(ws + WS_VC) + (size_t)(b * 4 + h) * NT64 * 8192 + wid * 1024 + lane * 16; }
    else { ksrc = (const char*)(ws + WS_KB) + ((size_t)b * NT64 * 8 + wid) * 1024 + lane * 16;
           vsrc = (const char*)(ws + WS_VB) + (size_t)b * NT64 * 8192 + wid * 1024 + lane * 16; }
    const unsigned kdst = lds0 + AT_KOFF + wid * 1024, kdst2 = lds0 + AT_KOFF + (8 + (wid & 3)) * 1024, vdst = lds0 + AT_VOFF + wid * 1024;
#define DMA_TILE(t, slot) do { glds16(ksrc + (size_t)(t) * 8192, (unsigned)__builtin_amdgcn_readfirstlane(kdst + (slot) * KSLOT)); \
        if (VAR == 0 && wid < 4) glds16(ksrc2 + (size_t)(t) * kstep2, (unsigned)__builtin_amdgcn_readfirstlane(kdst2 + (slot) * KSLOT)); \
        glds16(vsrc + (size_t)(t) * 8192, (unsigned)__builtin_amdgcn_readfirstlane(vdst + (slot) * VSLOT)); } while (0)
    DMA_TILE(0, 0);
    bf16x8 qf[NC * ND0];
    {
        const bf16_t* qp;
        if (VAR == 0) qp = (const bf16_t*)(ws + WS_QA) + (size_t)qrow * NQ_UP + h * 96 + 8 * hi;
        else if (VAR == 1) qp = (const bf16_t*)(ws + WS_QC) + (size_t)qrow * 256 + h * 64 + 8 * hi;
        else qp = (const bf16_t*)(ws + WS_QB) + (size_t)qrow * 256 + h * 64 + 8 * hi;
#pragma unroll
        for (int i = 0; i < NC * ND0; ++i) qf[i] = *(const GAS bf16x8*)(qp + 16 * i);
    }
    LAS float* lutl = (LAS float*)(lds + AT_LUT);
    int qpos = 0; float bfar = 0.f; int pminq = 0;
    if (VAR != 0) {
        const int hb = (VAR == 1) ? 4 + h : h;
        if (tid < 129) lutl[tid] = ((const float*)(ws + WS_MISC))[tid * 8 + hb];
        qpos = p.pos[qrow];
        bfar = ((const float*)(ws + WS_MISC))[128 * 8 + hb];
        pminq = ((const int*)(ws + WS_MISC + MISC_PMIN32))[(b * S + q0 + wid * 32) >> 5];
    }
    const int* pmax64 = (const int*)(ws + WS_MISC + MISC_PMAX64) + b * NT64;
    const unsigned* bmrow = (const unsigned*)(ws + WS_BM) + (size_t)qrow * 128;
    u32x2 bmw = {0u, 0u};
    if (VAR == 2) bmw = *(const GAS u32x2*)(bmrow);
    float m_run[NC], l_run[NC]; f32x16 oT[NC][2];
#pragma unroll
    for (int c = 0; c < NC; ++c) { m_run[c] = -1e30f; l_run[c] = 0.f; oT[c][0] = f32x16{}; oT[c][1] = f32x16{}; }
    const int vpoff = ((lane >> 4) & 1) * 32 + (lane & 3) * 8 + (4 * hi + ((lane & 15) >> 2)) * 64;
    const int kpoff = hi * 1024 + r32 * 16;

    for (int j = 0; j < NT; ++j) {
        WAIT_BAR0();
        if (j + 1 < NT) DMA_TILE(j + 1, (j + 1) & 1);
        u32x2 bmw_next = {0u, 0u};
        if (VAR == 2 && j + 1 < NT) bmw_next = *(const GAS u32x2*)(bmrow + 2 * (j + 1));
        const lds_cptr ks = (lds_cptr)lds + AT_KOFF + (j & 1) * KSLOT + kpoff;
        const lds_cptr vs = (lds_cptr)lds + AT_VOFF + (j & 1) * VSLOT + vpoff;
        bool far = true; float boff = 0.f;
        if (VAR != 0) { far = (pminq - pmax64[j]) >= 113; boff = far ? bfar : 0.f; }

#pragma unroll
        for (int c = 0; c < NC; ++c) {
            __builtin_amdgcn_sched_barrier(0);
            f32x16 s0 = f32x16{}, s1 = f32x16{};
#pragma unroll
            for (int d0 = 0; d0 < ND0; ++d0) {
                const bf16x8 ka = *(const LAS bf16x8*)(ks + c * 4096 + d0 * 2048), kb = *(const LAS bf16x8*)(ks + c * 4096 + d0 * 2048 + 512);
                s0 = MFMA32(ka, qf[c * ND0 + d0], s0); s1 = MFMA32(kb, qf[c * ND0 + d0], s1);
            }
            __builtin_amdgcn_sched_barrier(0);
            if (VAR != 0 && !far) {
#pragma unroll
                for (int g = 0; g < 4; ++g) {
                    const int kb0 = b * S + 64 * j + 8 * g + 4 * hi;
                    const int4 kp0 = *(const int4*)(p.pos + kb0), kp1 = *(const int4*)(p.pos + kb0 + 32);
                    const int k0[4] = {kp0.x, kp0.y, kp0.z, kp0.w}, k1[4] = {kp1.x, kp1.y, kp1.z, kp1.w};
#pragma unroll
                    for (int i = 0; i < 4; ++i) { int r0 = qpos - k0[i]; r0 = r0 < 0 ? 0 : (r0 > 128 ? 128 : r0); int r1 = qpos - k1[i]; r1 = r1 < 0 ? 0 : (r1 > 128 ? 128 : r1);
                        s0[4 * g + i] += lutl[r0]; s1[4 * g + i] += lutl[r1]; }
                    __builtin_amdgcn_sched_barrier(0);
                }
            }
            if (VAR != 2) { if (j >= NT - 4) {
#pragma unroll
                for (int r = 0; r < 16; ++r) { const int kv = 64 * j + crow(r, hi); if (kv > qidx) s0[r] = NEG_INF; if (kv + 32 > qidx) s1[r] = NEG_INF; } } }
            else {
#pragma unroll
                for (int r = 0; r < 16; ++r) { const int sh = crow(r, hi); if (!((bmw.x >> sh) & 1u)) s0[r] = NEG_INF; if (!((bmw.y >> sh) & 1u)) s1[r] = NEG_INF; } }
            u32x4 pw[4];
            const float tmax = rowmax32(s0, s1) + boff;
            const float m_new = fmaxf(m_run[c], tmax);
            if (__any(m_new > m_run[c])) {
                const float alpha = __builtin_amdgcn_exp2f(m_run[c] - m_new);
                l_run[c] *= alpha;
#pragma unroll
                for (int r = 0; r < 16; ++r) { oT[c][0][r] *= alpha; oT[c][1][r] *= alpha; }
                m_run[c] = m_new;
            }
            const float nm = boff - m_run[c];
            float rs = 0.f;
#pragma unroll
            for (int r = 0; r < 16; ++r) { s0[r] = __builtin_amdgcn_exp2f(s0[r] + nm); s1[r] = __builtin_amdgcn_exp2f(s1[r] + nm); rs += s0[r] + s1[r]; }
            l_run[c] += rs;
            pw[0] = (u32x4){cvtpk(s0[0], s0[1]), cvtpk(s0[2], s0[3]), cvtpk(s0[4], s0[5]), cvtpk(s0[6], s0[7])};
            pw[1] = (u32x4){cvtpk(s0[8], s0[9]), cvtpk(s0[10], s0[11]), cvtpk(s0[12], s0[13]), cvtpk(s0[14], s0[15])};
            pw[2] = (u32x4){cvtpk(s1[0], s1[1]), cvtpk(s1[2], s1[3]), cvtpk(s1[4], s1[5]), cvtpk(s1[6], s1[7])};
            pw[3] = (u32x4){cvtpk(s1[8], s1[9]), cvtpk(s1[10], s1[11]), cvtpk(s1[12], s1[13]), cvtpk(s1[14], s1[15])};
            __builtin_amdgcn_sched_barrier(0);
#pragma unroll
        for (int ksp = 0; ksp < 4; ++ksp) {
            __builtin_amdgcn_sched_barrier(0);
#pragma unroll
            for (int db = 0; db < 2; ++db) {
                const s16x4 vlo = vtr(vs + db * 4096 + ksp * 1024), vhi = vtr(vs + db * 4096 + ksp * 1024 + 512);
                const bf16x8 vf = (bf16x8){vlo[0], vlo[1], vlo[2], vlo[3], vhi[0], vhi[1], vhi[2], vhi[3]};
                oT[c][db] = MFMA32(vf, __builtin_bit_cast(bf16x8, pw[ksp]), oT[c][db]);
            }
        }
        }
        bmw = bmw_next;
    }
#undef DMA_TILE
    float o[2][16];
    if (VAR == 1) {
        const float* lp = p.diff_lambda + layer * 128; float d01 = 0.f, d23 = 0.f;
        for (int i = 0; i < 32; ++i) { d01 += lp[i] * lp[32 + i]; d23 += lp[64 + i] * lp[96 + i]; }
        const float lam_init = lam_init_of(layer), lam = expf(d01) - expf(d23) + lam_init;
        const float i0 = 1.0f / xhalf_sum(l_run[0]), i1 = lam / xhalf_sum(l_run[NC - 1]);
        float ss = 0.f;
#pragma unroll
        for (int db = 0; db < 2; ++db)
#pragma unroll
            for (int r = 0; r < 16; ++r) { const float v = oT[0][db][r] * i0 - oT[NC - 1][db][r] * i1; o[db][r] = v; ss += v * v; }
        ss = xhalf_sum(ss);
        const float rsn = 1.0f / sqrtf(ss / 64.f + EPS) * (1.f - lam_init);
        const float* g = p.diff_subln + layer * 64;
#pragma unroll
        for (int db = 0; db < 2; ++db)
#pragma unroll
            for (int r = 0; r < 16; ++r) o[db][r] *= rsn * g[32 * db + crow(r, hi)];
    } else {
        const float il = 1.0f / xhalf_sum(l_run[0]);
#pragma unroll
        for (int db = 0; db < 2; ++db)
#pragma unroll
            for (int r = 0; r < 16; ++r) o[db][r] = oT[0][db][r] * il;
    }
    bf16_t* mix = (bf16_t*)(ws + WS_MIX) + (size_t)qrow * DM + (VAR == 0 ? h * 64 : (VAR == 2 ? 512 + h * 64 : 768 + h * 64)) + 4 * hi;
#pragma unroll
    for (int db = 0; db < 2; ++db)
#pragma unroll
        for (int g = 0; g < 4; ++g) { u32x2 w; w.x = pk2(o[db][4 * g], o[db][4 * g + 1]); w.y = pk2(o[db][4 * g + 2], o[db][4 * g + 3]); *(GAS u32x2*)(mix + 32 * db + 8 * g) = w; }
    WAIT_BAR0();
}
#define SBAR() __builtin_amdgcn_sched_barrier(0)
#define PIN(x) asm volatile("" : "+v"(x))
constexpr int A2_KSLOT = 12288, A2_VSLOT = 8192, A2_KOFF = 0, A2_VOFF = 3 * A2_KSLOT, A2_LUT = A2_VOFF + 3 * A2_VSLOT, A2_END = A2_LUT + 1024;
constexpr float A2_THR = 8.f;
__device__ __forceinline__ void wait_bar_n(int n) {
    if (n == 0) asm volatile("s_waitcnt vmcnt(0) lgkmcnt(0)\n\ts_barrier" ::: "memory");
    else if (n == 1) asm volatile("s_waitcnt vmcnt(1) lgkmcnt(0)\n\ts_barrier" ::: "memory");
    else if (n == 2) asm volatile("s_waitcnt vmcnt(2) lgkmcnt(0)\n\ts_barrier" ::: "memory");
    else asm volatile("s_waitcnt vmcnt(3) lgkmcnt(0)\n\ts_barrier" ::: "memory");
}
__device__ __forceinline__ float rowmax32f(const f32x16& p0, const f32x16& p1) {
#define MX3(a, b, c) __builtin_fmaxf(__builtin_fmaxf((a), (b)), (c))
    float a = MX3(p0[0], p0[1], p1[0]), b = MX3(p0[2], p0[3], p1[1]); a = MX3(a, p1[2], p1[3]);
#pragma unroll
    for (int r = 4; r < 16; r += 4) { a = MX3(a, p0[r], p0[r + 1]); b = MX3(b, p0[r + 2], p0[r + 3]); a = MX3(a, p1[r], p1[r + 1]); b = MX3(b, p1[r + 2], p1[r + 3]); }
#undef MX3
    return xhalf_max(__builtin_fmaxf(a, b)); }

template <int VAR> __device__ __forceinline__ void attn_unit_p(const P& p, int layer, int b, int h, int qb, LAS unsigned char* lds, int wave) {
    static_assert(VAR == 0 || VAR == 2, "single-map variants");
    constexpr int ND0 = (VAR == 0) ? 6 : 4, NQK = 2 * ND0;
    constexpr bool TUPLE = true;
    constexpr bool NEGM = false;
    const int tid = phase_tid(wave), lane = tid & 63, r32 = lane & 31, hi = lane >> 5, wid = wave;
    const int q0 = qb * 256, NT = 4 * (qb + 1);
    const int qidx = q0 + wid * 32 + r32, qrow = b * S + qidx;
    const unsigned char* ws = p.ws; asm volatile("" : "+s"(ws));
    const unsigned lds0 = (unsigned)(uintptr_t)lds;
    const char* ksrc; const char* ksrc2 = nullptr; const char* vsrc;
    if (VAR == 0) { ksrc = (const char*)(ws + WS_KN) + ((size_t)(b * 8 + h) * NT64 * 8 + wid) * 1024 + lane * 16;
                    ksrc2 = (const char*)(ws + WS_KR) + ((size_t)b * NT64 * 4 + (wid & 3)) * 1024 + lane * 16;
                    vsrc = (const char*)(ws + WS_VA) + (size_t)(b * 8 + h) * NT64 * 8192 + wid * 1024 + lane * 16; }
    else { ksrc = (const char*)(ws + WS_KB) + ((size_t)b * NT64 * 8 + wid) * 1024 + lane * 16;
           vsrc = (const char*)(ws + WS_VB) + (size_t)b * NT64 * 8192 + wid * 1024 + lane * 16; }
    const unsigned kdst = lds0 + A2_KOFF + wid * 1024, kdst2 = lds0 + A2_KOFF + (8 + (wid & 3)) * 1024, vdst = lds0 + A2_VOFF + wid * 1024;
    const bool k2 = (VAR == 0) && (wid < 4);
    const int nkd = k2 ? 2 : 1;
#define DMA_K(t, slot) do { glds16(ksrc + (size_t)(t) * 8192, (unsigned)__builtin_amdgcn_readfirstlane(kdst + (slot) * A2_KSLOT)); \
        if (k2) glds16(ksrc2 + (size_t)(t) * 4096, (unsigned)__builtin_amdgcn_readfirstlane(kdst2 + (slot) * A2_KSLOT)); } while (0)
#define DMA_V(t, slot) glds16(vsrc + (size_t)(t) * 8192, (unsigned)__builtin_amdgcn_readfirstlane(vdst + (slot) * A2_VSLOT))
    DMA_K(0, 0); DMA_V(0, 0); DMA_K(1, 1); DMA_K(2, 2);
    bf16x8 qf[ND0];
    {
        const bf16_t* qp = (VAR == 0) ? (const bf16_t*)(ws + WS_QA) + (size_t)qrow * NQ_UP + h * 96 + 8 * hi : (const bf16_t*)(ws + WS_QB) + (size_t)qrow * 256 + h * 64 + 8 * hi;
#pragma unroll
        for (int i = 0; i < ND0; ++i) qf[i] = *(const GAS bf16x8*)(qp + 16 * i);
    }
    LAS float* lutl = (LAS float*)(lds + A2_LUT);
    float bfar = 0.f;
    if (VAR == 2) {
        if (tid < 252) { int ri = tid - 64; ri = ri < 0 ? 0 : (ri > 128 ? 128 : ri); lutl[tid] = ((const float*)(ws + WS_MISC))[ri * 8 + h]; }
        bfar = ((const float*)(ws + WS_MISC))[128 * 8 + h];
    }
    const unsigned* bmrow = (const unsigned*)(ws + WS_BM) + (size_t)qrow * 128;
    const lds_cptr vp0 = (lds_cptr)lds + A2_VOFF + ((lane >> 4) & 1) * 32 + (lane & 3) * 8 + (4 * hi + ((lane & 15) >> 2)) * 64;
    const lds_cptr kp0 = (lds_cptr)lds + A2_KOFF + hi * 1024 + r32 * 16;
    float mhat = 0.f, l_reg = 0.f, fresc = 1.f; bool resc = false;
    f32x16 oT[2]; oT[0] = f32x16{}; oT[1] = f32x16{};
    f32x16 negm;
    f32x16 pA0, pA1, pB0, pB1; bf16x8 kf[NQK]; s16x4 vlo[8], vhi[8]; u32x4 pw0, pw1, pw2, pw3;
    int sl_prev = 0, sl_cur = 0, sl_next = 1;
#define ROT() do { sl_prev = sl_cur; sl_cur = sl_next; sl_next = (sl_next == 2) ? 0 : sl_next + 1; } while (0)
#define KLOAD(slot, d0) do { kf[2 * (d0)] = *(const LAS bf16x8*)(kp0 + (slot) * A2_KSLOT + (d0) * 2048); kf[2 * (d0) + 1] = *(const LAS bf16x8*)(kp0 + (slot) * A2_KSLOT + (d0) * 2048 + 512); } while (0)
#define FILLNEG() do { if (NEGM) { const float nv_ = bfar - mhat; _Pragma("unroll") for (int r = 0; r < 16; ++r) negm[r] = nv_; PIN(negm); } } while (0)
#define NEARFILL(C0, C1, t) do { \
        int bb_ = qidx - 64 * (t) - 4 * hi; bb_ = bb_ > 187 ? 187 : (bb_ < -5 ? -5 : bb_); const LAS float* lp_ = lutl + (bb_ + 5); \
        _Pragma("unroll") for (int r = 0; r < 16; ++r) { const int off_ = 8 * (r >> 2) + (r & 3); C0[r] = lp_[59 - off_] - mhat; C1[r] = lp_[27 - off_] - mhat; } \
        PIN(C0); PIN(C1); } while (0)
#define FIXUP(C0, C1, t, MASK, BW) do { \
        if (VAR == 2) { \
            const u32x2 bw_ = (BW); \
            _Pragma("unroll") for (int r = 0; r < 16; ++r) { const int sh = crow(r, hi); if (!((bw_.x >> sh) & 1u)) C0[r] = NEG_INF; if (!((bw_.y >> sh) & 1u)) C1[r] = NEG_INF; if ((r & 3) == 3) { PIN(C0); PIN(C1); SBAR(); } } \
        } else if (MASK) { \
            _Pragma("unroll") for (int r = 0; r < 16; ++r) { const int kv = 64 * (t) + crow(r, hi); if (kv > qidx) C0[r] = NEG_INF; if (kv + 32 > qidx) C1[r] = NEG_INF; } } \
    } while (0)
    u32x2 bmw = {0u, 0u}, bmw1 = {0u, 0u};
    if (VAR == 2) { bmw = *(const GAS u32x2*)(bmrow); bmw1 = *(const GAS u32x2*)(bmrow + 2); }
    wait_bar_n(0);
#pragma unroll
    for (int d0 = 0; d0 < ND0; ++d0) KLOAD(0, d0);
    {
        mhat = 0.f;
        f32x16 z = f32x16{};
        pA0 = z; pA1 = z;
        const bool near0 = (VAR == 2) && (((q0 + wid * 32) - 63) < 113);
        if (near0) NEARFILL(pA0, pA1, 0);
        const float b0 = (VAR == 2 && !near0) ? bfar : 0.f;
#pragma unroll
        for (int d0 = 0; d0 < ND0; ++d0) { pA0 = MFMA32(kf[2 * d0], qf[d0], pA0); pA1 = MFMA32(kf[2 * d0 + 1], qf[d0], pA1); }
        FIXUP(pA0, pA1, 0, (NT == 4), bmw);
        const float rm = rowmax32f(pA0, pA1) + b0;
        mhat = (VAR == 2) ? __builtin_fmaxf(rm, -40.f) : rm;
        { const float nm0 = b0 - mhat;
#pragma unroll
        for (int r = 0; r < 16; ++r) { pA0[r] = __builtin_amdgcn_exp2f(pA0[r] + nm0); pA1[r] = __builtin_amdgcn_exp2f(pA1[r] + nm0); } }
        FILLNEG();
        if (VAR == 0) { const float cv_ = bfar - mhat; _Pragma("unroll") for (int r = 0; r < 16; ++r) { pB0[r] = cv_; pB1[r] = cv_; } }
    }
    if (NT > 1) {
#pragma unroll
        for (int d0 = 0; d0 < ND0; ++d0) KLOAD(1, d0);
    }
    wait_bar_n(0);
    if (VAR == 2) bmw = bmw1;
    if (3 < NT) DMA_K(3, 0);
    DMA_V(1, 1); ROT();

#define PKW(P, i) cvtpk(P[i], P[i + 1])
#define PAF(k) __builtin_bit_cast(bf16x8, pw##k)
#define VFR(i) (bf16x8){vlo[i][0], vlo[i][1], vlo[i][2], vlo[i][3], vhi[i][0], vhi[i][1], vhi[i][2], vhi[i][3]}
#define VRD(i) do { vlo[i] = vtr(vp_ + (((i) >> 2) * 4096 + ((i) & 3) * 1024)); vhi[i] = vtr(vp_ + (((i) >> 2) * 4096 + ((i) & 3) * 1024 + 512)); } while (0)
#define EX4N(X, i, nm) do { X[i] = __builtin_amdgcn_exp2f(X[i] + (nm)); X[i + 1] = __builtin_amdgcn_exp2f(X[i + 1] + (nm)); X[i + 2] = __builtin_amdgcn_exp2f(X[i + 2] + (nm)); X[i + 3] = __builtin_amdgcn_exp2f(X[i + 3] + (nm)); PIN(X); } while (0)
#define EX4(X, i) do { X[i] = __builtin_amdgcn_exp2f(X[i]); X[i + 1] = __builtin_amdgcn_exp2f(X[i + 1]); X[i + 2] = __builtin_amdgcn_exp2f(X[i + 2]); X[i + 3] = __builtin_amdgcn_exp2f(X[i + 3]); PIN(X); } while (0)
#define GAPA(C0, C1, P0, P1, g) do { \
        if ((g) < 8) { VRD(((g) >> 1) + 4 * ((g) & 1)); SBAR(); }                                    \
        if ((g) >= 2 || near_ || !NEGM) { if (((g) & 1) == 0) C0 = MFMA32(kf[g], qf[(g) >> 1], C0); else C1 = MFMA32(kf[g], qf[(g) >> 1], C1); } \
        else { if (((g) & 1) == 0) C0 = MFMA32(kf[g], qf[(g) >> 1], negm); else C1 = MFMA32(kf[g], qf[(g) >> 1], negm); } \
        if ((g) < 8) { const int a_ = 4 * (g); \
            if (a_ < 16) { sacc += P0[a_]; sacc += P0[a_ + 1]; sacc += P0[a_ + 2]; sacc += P0[a_ + 3]; } else { sacc += P1[a_ - 16]; sacc += P1[a_ - 15]; sacc += P1[a_ - 14]; sacc += P1[a_ - 13]; } \
            if ((g) == 0) { pw0[0] = PKW(P0, 0); pw0[1] = PKW(P0, 2); PIN(pw0); } if ((g) == 1) { pw0[2] = PKW(P0, 4); pw0[3] = PKW(P0, 6); PIN(pw0); } \
            if ((g) == 2) { pw1[0] = PKW(P0, 8); pw1[1] = PKW(P0, 10); PIN(pw1); } if ((g) == 3) { pw1[2] = PKW(P0, 12); pw1[3] = PKW(P0, 14); PIN(pw1); } \
            if ((g) == 4) { pw2[0] = PKW(P1, 0); pw2[1] = PKW(P1, 2); PIN(pw2); } if ((g) == 5) { pw2[2] = PKW(P1, 4); pw2[3] = PKW(P1, 6); PIN(pw2); } \
            if ((g) == 6) { pw3[0] = PKW(P1, 8); pw3[1] = PKW(P1, 10); PIN(pw3); } if ((g) == 7) { pw3[2] = PKW(P1, 12); pw3[3] = PKW(P1, 14); PIN(pw3); } \
            PIN(sacc); } \
        if (VAR == 0 && (g) >= 8) { const float cvn_ = bfar - mhat; const int e_ = 4 * ((g) - 8);                                       \
            P0[e_] = cvn_; P0[e_ + 1] = cvn_; P0[e_ + 2] = cvn_; P0[e_ + 3] = cvn_; P1[e_] = cvn_; P1[e_ + 1] = cvn_; P1[e_ + 2] = cvn_; P1[e_ + 3] = cvn_; PIN(P0); PIN(P1); } \
        SBAR(); } while (0)
#define STEP(C0, C1, P0, P1, t, MASK, GK, GV, GL) do { SBAR(); \
        const lds_cptr vp_ = vp0 + sl_prev * A2_VSLOT; float sacc = 0.f; \
        const bool near_ = (VAR == 2) && (((q0 + wid * 32) - (64 * (t) + 63)) < 113); \
        if (near_) NEARFILL(C0, C1, t); \
        else if (VAR == 2) {                                       \
            const unsigned cvb_ = __float_as_uint(bfar - mhat), wx_ = bmw.x >> (4 * hi), wy_ = bmw.y >> (4 * hi); \
            _Pragma("unroll") for (int r = 0; r < 16; ++r) { const int cb_ = (r & 3) + 8 * (r >> 2); \
                const unsigned m0_ = (unsigned)__builtin_amdgcn_sbfe((int)wx_, cb_, 1), m1_ = (unsigned)__builtin_amdgcn_sbfe((int)wy_, cb_, 1); \
                C0[r] = __uint_as_float((m0_ & cvb_) | (~m0_ & 0xff800000u)); C1[r] = __uint_as_float((m1_ & cvb_) | (~m1_ & 0xff800000u)); } \
            PIN(C0); PIN(C1); } \
        else if (!NEGM && VAR != 0) { const float cv_ = bfar - mhat; _Pragma("unroll") for (int r = 0; r < 16; ++r) { C0[r] = cv_; C1[r] = cv_; } PIN(C0); PIN(C1); } \
        u32x2 bwn_ = {0u, 0u}; if (VAR == 2 && (t) + 1 < NT) bwn_ = *(const GAS u32x2*)(bmrow + 2 * ((t) + 1));     \
        _Pragma("unroll") for (int g_ = 0; g_ < NQK; ++g_) GAPA(C0, C1, P0, P1, g_); \
        l_reg += sacc; \
        if (VAR != 2 || near_) FIXUP(C0, C1, t, MASK, bmw); \
        bmw = bwn_; \
        if (GK) DMA_K((t) + 3, sl_cur); if (GV) DMA_V((t) + 1, sl_next);                            \
        float nm_ = TUPLE ? 0.f : ((near_ ? 0.f : bfar) - mhat);                                    \
        { const float rm = rowmax32f(C0, C1) + nm_; resc = false;                                    \
          if (__builtin_expect(__any(rm > A2_THR), 0)) { const float dl = __builtin_fmaxf(rm, 0.f); mhat += dl; fresc = __builtin_amdgcn_exp2f(-dl); l_reg *= fresc; resc = true; \
              if (TUPLE) { _Pragma("unroll") for (int r = 0; r < 16; ++r) { C0[r] -= dl; C1[r] -= dl; } FILLNEG(); } else nm_ -= dl; \
              if (VAR == 0) { const float cvn_ = bfar - mhat; _Pragma("unroll") for (int r = 0; r < 16; ++r) { P0[r] = cvn_; P1[r] = cvn_; } PIN(P0); PIN(P1); } } } \
        SBAR(); \
        _Pragma("unroll") for (int i_ = 0; i_ < 8; ++i_) { \
            if (GL && i_ >= 1 && i_ - 1 < ND0) { KLOAD(sl_next, i_ - 1); SBAR(); } \
            { const int ks_ = i_ >> 1, db_ = i_ & 1, vi_ = 4 * db_ + ks_; \
              const bf16x8 pa_ = (ks_ == 0) ? PAF(0) : (ks_ == 1) ? PAF(1) : (ks_ == 2) ? PAF(2) : PAF(3); \
              oT[db_] = MFMA32(VFR(vi_), pa_, oT[db_]); } \
            if (TUPLE) { if (i_ < 4) EX4(C0, 4 * i_); else EX4(C1, 4 * (i_ - 4)); } else { if (i_ < 4) EX4N(C0, 4 * i_, nm_); else EX4N(C1, 4 * (i_ - 4), nm_); } \
            SBAR(); } \
    } while (0)
#define RESC() do { if (resc) { _Pragma("unroll") for (int r = 0; r < 16; ++r) { oT[0][r] *= fresc; oT[1][r] *= fresc; } } } while (0)
    int t = 1;
    for (; t + 5 < NT; t += 2) {
        STEP(pB0, pB1, pA0, pA1, t, false, true, true, true);     wait_bar_n(nkd + 1); RESC(); ROT();
        STEP(pA0, pA1, pB0, pB1, t + 1, false, true, true, true); wait_bar_n(nkd + 1); RESC(); ROT();
    }
#define ENDW(tt) do { if ((tt) + 3 < NT) wait_bar_n(nkd + 1); else if ((tt) + 2 < NT) wait_bar_n(1); else wait_bar_n(0); } while (0)
    for (; t + 1 < NT; t += 2) {
        STEP(pB0, pB1, pA0, pA1, t, true, (t + 3 < NT), (t + 1 < NT), (t + 1 < NT));         ENDW(t);     RESC(); ROT();
        STEP(pA0, pA1, pB0, pB1, t + 1, true, (t + 4 < NT), (t + 2 < NT), (t + 2 < NT));     ENDW(t + 1); RESC(); ROT();
    }
    STEP(pB0, pB1, pA0, pA1, NT - 1, true, false, false, false); RESC();
    { float sacc = 0.f;
#pragma unroll
      for (int r = 0; r < 16; ++r) sacc += pB0[r] + pB1[r];
      l_reg += sacc;
      pw0 = (u32x4){PKW(pB0, 0), PKW(pB0, 2), PKW(pB0, 4), PKW(pB0, 6)}; pw1 = (u32x4){PKW(pB0, 8), PKW(pB0, 10), PKW(pB0, 12), PKW(pB0, 14)};
      pw2 = (u32x4){PKW(pB1, 0), PKW(pB1, 2), PKW(pB1, 4), PKW(pB1, 6)}; pw3 = (u32x4){PKW(pB1, 8), PKW(pB1, 10), PKW(pB1, 12), PKW(pB1, 14)};
      const lds_cptr vp_ = vp0 + sl_cur * A2_VSLOT;
#pragma unroll
      for (int i = 0; i < 8; ++i) VRD(i);
#pragma unroll
      for (int ks = 0; ks < 4; ++ks) { const bf16x8 pa_ = (ks == 0) ? PAF(0) : (ks == 1) ? PAF(1) : (ks == 2) ? PAF(2) : PAF(3);
          oT[0] = MFMA32(VFR(ks), pa_, oT[0]); oT[1] = MFMA32(VFR(4 + ks), pa_, oT[1]); } }
    const float il = 1.0f / xhalf_sum(l_reg);
    bf16_t* mix = (bf16_t*)(ws + WS_MIX) + (size_t)qrow * DM + (VAR == 0 ? h * 64 : 512 + h * 64) + 4 * hi;
#pragma unroll
    for (int db = 0; db < 2; ++db)
#pragma unroll
        for (int g = 0; g < 4; ++g) { u32x2 w; w.x = pk2(oT[db][4 * g] * il, oT[db][4 * g + 1] * il); w.y = pk2(oT[db][4 * g + 2] * il, oT[db][4 * g + 3] * il); *(GAS u32x2*)(mix + 32 * db + 8 * g) = w; }
    wait_bar_n(0);
#undef DMA_K
#undef DMA_V
#undef ROT
#undef KLOAD
#undef FILLNEG
#undef FIXUP
#undef NEARFILL
#undef PKW
#undef PAF
#undef VFR
#undef VRD
#undef EX4
#undef EX4N
#undef GAPA
#undef STEP
#undef RESC
#undef ENDW
}
constexpr int Q2_KOFF = 0, Q2_VOFF = 4 * A2_KSLOT, Q2_LUT = Q2_VOFF + 4 * A2_VSLOT, Q2_END = Q2_LUT + 1024;
template <int VAR> __device__ __forceinline__ void attn_unit_q(const P& p, int layer, int b, int h, int qb, LAS unsigned char* lds, int wave) {
    static_assert(VAR == 0 || VAR == 2, "single-map variants");
    constexpr int ND0 = (VAR == 0) ? 6 : 4, NQK = 2 * ND0;
    constexpr bool TUPLE = true;
    constexpr bool NEGM = false;
    const int tid = phase_tid(wave), lane = tid & 63, r32 = lane & 31, hi = lane >> 5, wid = wave;
    const int q0 = qb * 256, NT = 4 * (qb + 1);
    const int qidx = q0 + wid * 32 + r32, qrow = b * S + qidx;
    const unsigned char* ws = p.ws; asm volatile("" : "+s"(ws));
    const unsigned lds0 = (unsigned)(uintptr_t)lds;
    const char* ksrc; const char* ksrc2 = nullptr; const char* vsrc;
    if (VAR == 0) { ksrc = (const char*)(ws + WS_KN) + ((size_t)(b * 8 + h) * NT64 * 8 + wid) * 1024 + lane * 16;
                    ksrc2 = (const char*)(ws + WS_KR) + ((size_t)b * NT64 * 4 + (wid & 3)) * 1024 + lane * 16;
                    vsrc = (const char*)(ws + WS_VA) + (size_t)(b * 8 + h) * NT64 * 8192 + wid * 1024 + lane * 16; }
    else { ksrc = (const char*)(ws + WS_KB) + ((size_t)b * NT64 * 8 + wid) * 1024 + lane * 16;
           vsrc = (const char*)(ws + WS_VB) + (size_t)b * NT64 * 8192 + wid * 1024 + lane * 16; }
    const unsigned kdst = lds0 + Q2_KOFF + wid * 1024, kdst2 = lds0 + Q2_KOFF + (8 + (wid & 3)) * 1024, vdst = lds0 + Q2_VOFF + wid * 1024;
    const bool k2 = (VAR == 0) && (wid < 4);
    const int nkd = k2 ? 2 : 1;
#define DMA_K(t, slot) do { glds16(ksrc + (size_t)(t) * 8192, (unsigned)__builtin_amdgcn_readfirstlane(kdst + (slot) * A2_KSLOT)); \
        if (k2) glds16(ksrc2 + (size_t)(t) * 4096, (unsigned)__builtin_amdgcn_readfirstlane(kdst2 + (slot) * A2_KSLOT)); } while (0)
#define DMA_V(t, slot) glds16(vsrc + (size_t)(t) * 8192, (unsigned)__builtin_amdgcn_readfirstlane(vdst + (slot) * A2_VSLOT))
    DMA_K(0, 2); DMA_K(1, 3); DMA_V(0, 0); DMA_V(1, 1); DMA_K(2, 0); DMA_K(3, 1);
    bf16x8 qf[ND0];
    {
        const bf16_t* qp = (VAR == 0) ? (const bf16_t*)(ws + WS_QA) + (size_t)qrow * NQ_UP + h * 96 + 8 * hi : (const bf16_t*)(ws + WS_QB) + (size_t)qrow * 256 + h * 64 + 8 * hi;
#pragma unroll
        for (int i = 0; i < ND0; ++i) qf[i] = *(const GAS bf16x8*)(qp + 16 * i);
    }
    LAS float* lutl = (LAS float*)(lds + Q2_LUT);
    float bfar = 0.f;
    if (VAR == 2) {
        if (tid < 252) { int ri = tid - 64; ri = ri < 0 ? 0 : (ri > 128 ? 128 : ri); lutl[tid] = ((const float*)(ws + WS_MISC))[ri * 8 + h]; }
        bfar = ((const float*)(ws + WS_MISC))[128 * 8 + h];
    }
    const unsigned* bmrow = (const unsigned*)(ws + WS_BM) + (size_t)qrow * 128;
    const lds_cptr vp0 = (lds_cptr)lds + Q2_VOFF + ((lane >> 4) & 1) * 32 + (lane & 3) * 8 + (4 * hi + ((lane & 15) >> 2)) * 64;
    const lds_cptr kp0 = (lds_cptr)lds + Q2_KOFF + hi * 1024 + r32 * 16;
    float mhat = 0.f, l_reg = 0.f, fresc = 1.f; bool resc = false;
    f32x16 oT[2]; oT[0] = f32x16{}; oT[1] = f32x16{};
    f32x16 negm;
    f32x16 pA0, pA1, pB0, pB1; bf16x8 kf[NQK]; s16x4 vlo[8], vhi[8]; u32x4 pw0, pw1, pw2, pw3;
#define KLOAD(slot, d0) do { kf[2 * (d0)] = *(const LAS bf16x8*)(kp0 + (slot) * A2_KSLOT + (d0) * 2048); kf[2 * (d0) + 1] = *(const LAS bf16x8*)(kp0 + (slot) * A2_KSLOT + (d0) * 2048 + 512); } while (0)
#define FILLNEG() do { if (NEGM) { const float nv_ = bfar - mhat; _Pragma("unroll") for (int r = 0; r < 16; ++r) negm[r] = nv_; PIN(negm); } } while (0)
#define NEARFILL(C0, C1, t) do { \
        int bb_ = qidx - 64 * (t) - 4 * hi; bb_ = bb_ > 187 ? 187 : (bb_ < -5 ? -5 : bb_); const LAS float* lp_ = lutl + (bb_ + 5); \
        _Pragma("unroll") for (int r = 0; r < 16; ++r) { const int off_ = 8 * (r >> 2) + (r & 3); C0[r] = lp_[59 - off_] - mhat; C1[r] = lp_[27 - off_] - mhat; } \
        PIN(C0); PIN(C1); } while (0)
#define FIXUP(C0, C1, t, MASK, BW) do { \
        if (VAR == 2) { \
            const u32x2 bw_ = (BW); \
            _Pragma("unroll") for (int r = 0; r < 16; ++r) { const int sh = crow(r, hi); if (!((bw_.x >> sh) & 1u)) C0[r] = NEG_INF; if (!((bw_.y >> sh) & 1u)) C1[r] = NEG_INF; if ((r & 3) == 3) { PIN(C0); PIN(C1); SBAR(); } } \
        } else if (MASK) { \
            _Pragma("unroll") for (int r = 0; r < 16; ++r) { const int kv = 64 * (t) + crow(r, hi); if (kv > qidx) C0[r] = NEG_INF; if (kv + 32 > qidx) C1[r] = NEG_INF; } } \
    } while (0)
    u32x2 bmw = {0u, 0u}, bmw1 = {0u, 0u};
    if (VAR == 2) { bmw = *(const GAS u32x2*)(bmrow); bmw1 = *(const GAS u32x2*)(bmrow + 2); }
    wait_bar_n(0);
#pragma unroll
    for (int d0 = 0; d0 < ND0; ++d0) KLOAD(2, d0);
    {
        mhat = 0.f;
        f32x16 z = f32x16{};
        pA0 = z; pA1 = z;
        const bool near0 = (VAR == 2) && (((q0 + wid * 32) - 63) < 113);
        if (near0) NEARFILL(pA0, pA1, 0);
        const float b0 = (VAR == 2 && !near0) ? bfar : 0.f;
#pragma unroll
        for (int d0 = 0; d0 < ND0; ++d0) { pA0 = MFMA32(kf[2 * d0], qf[d0], pA0); pA1 = MFMA32(kf[2 * d0 + 1], qf[d0], pA1); }
        FIXUP(pA0, pA1, 0, (NT == 4), bmw);
        const float rm = rowmax32f(pA0, pA1) + b0;
        mhat = (VAR == 2) ? __builtin_fmaxf(rm, -40.f) : rm;
        { const float nm0 = b0 - mhat;
#pragma unroll
        for (int r = 0; r < 16; ++r) { pA0[r] = __builtin_amdgcn_exp2f(pA0[r] + nm0); pA1[r] = __builtin_amdgcn_exp2f(pA1[r] + nm0); } }
        FILLNEG();
        if (VAR == 0) { const float cv_ = bfar - mhat; _Pragma("unroll") for (int r = 0; r < 16; ++r) { pB0[r] = cv_; pB1[r] = cv_; } }
    }
    if (NT > 1) {
#pragma unroll
        for (int d0 = 0; d0 < ND0; ++d0) KLOAD(3, d0);
    }
    wait_bar_n(0);
    if (VAR == 2) bmw = bmw1;

#define PKW(P, i) cvtpk(P[i], P[i + 1])
#define PAF(k) __builtin_bit_cast(bf16x8, pw##k)
#define VFR(i) (bf16x8){vlo[i][0], vlo[i][1], vlo[i][2], vlo[i][3], vhi[i][0], vhi[i][1], vhi[i][2], vhi[i][3]}
#define VRD(i) do { vlo[i] = vtr(vp_ + (((i) >> 2) * 4096 + ((i) & 3) * 1024)); vhi[i] = vtr(vp_ + (((i) >> 2) * 4096 + ((i) & 3) * 1024 + 512)); } while (0)
#define EX4N(X, i, nm) do { X[i] = __builtin_amdgcn_exp2f(X[i] + (nm)); X[i + 1] = __builtin_amdgcn_exp2f(X[i + 1] + (nm)); X[i + 2] = __builtin_amdgcn_exp2f(X[i + 2] + (nm)); X[i + 3] = __builtin_amdgcn_exp2f(X[i + 3] + (nm)); PIN(X); } while (0)
#define EX4(X, i) do { X[i] = __builtin_amdgcn_exp2f(X[i]); X[i + 1] = __builtin_amdgcn_exp2f(X[i + 1]); X[i + 2] = __builtin_amdgcn_exp2f(X[i + 2]); X[i + 3] = __builtin_amdgcn_exp2f(X[i + 3]); PIN(X); } while (0)
#define GAPA(C0, C1, P0, P1, g) do { \
        if ((g) < 8) { VRD(((g) >> 1) + 4 * ((g) & 1)); SBAR(); }                                    \
        if ((g) >= 2 || near_ || !NEGM) { if (((g) & 1) == 0) C0 = MFMA32(kf[g], qf[(g) >> 1], C0); else C1 = MFMA32(kf[g], qf[(g) >> 1], C1); } \
        else { if (((g) & 1) == 0) C0 = MFMA32(kf[g], qf[(g) >> 1], negm); else C1 = MFMA32(kf[g], qf[(g) >> 1], negm); } \
        if ((g) < 8) { const int a_ = 4 * (g); \
            if (a_ < 16) { sacc += P0[a_]; sacc += P0[a_ + 1]; sacc += P0[a_ + 2]; sacc += P0[a_ + 3]; } else { sacc += P1[a_ - 16]; sacc += P1[a_ - 15]; sacc += P1[a_ - 14]; sacc += P1[a_ - 13]; } \
            if ((g) == 0) { pw0[0] = PKW(P0, 0); pw0[1] = PKW(P0, 2); PIN(pw0); } if ((g) == 1) { pw0[2] = PKW(P0, 4); pw0[3] = PKW(P0, 6); PIN(pw0); } \
            if ((g) == 2) { pw1[0] = PKW(P0, 8); pw1[1] = PKW(P0, 10); PIN(pw1); } if ((g) == 3) { pw1[2] = PKW(P0, 12); pw1[3] = PKW(P0, 14); PIN(pw1); } \
            if ((g) == 4) { pw2[0] = PKW(P1, 0); pw2[1] = PKW(P1, 2); PIN(pw2); } if ((g) == 5) { pw2[2] = PKW(P1, 4); pw2[3] = PKW(P1, 6); PIN(pw2); } \
            if ((g) == 6) { pw3[0] = PKW(P1, 8); pw3[1] = PKW(P1, 10); PIN(pw3); } if ((g) == 7) { pw3[2] = PKW(P1, 12); pw3[3] = PKW(P1, 14); PIN(pw3); } \
            PIN(sacc); } \
        if (VAR == 0 && (g) >= 8) { const float cvn_ = bfar - mhat; const int e_ = 4 * ((g) - 8);                                       \
            P0[e_] = cvn_; P0[e_ + 1] = cvn_; P0[e_ + 2] = cvn_; P0[e_ + 3] = cvn_; P1[e_] = cvn_; P1[e_ + 1] = cvn_; P1[e_ + 2] = cvn_; P1[e_ + 3] = cvn_; PIN(P0); PIN(P1); } \
        SBAR(); } while (0)
#define STEP(C0, C1, P0, P1, t, MASK, GL, VSL, KSL) do { SBAR(); \
        const lds_cptr vp_ = vp0 + (VSL) * A2_VSLOT; float sacc = 0.f; \
        const bool near_ = (VAR == 2) && (((q0 + wid * 32) - (64 * (t) + 63)) < 113); \
        if (near_) NEARFILL(C0, C1, t); \
        else if (VAR == 2) {                                       \
            const unsigned cvb_ = __float_as_uint(bfar - mhat), wx_ = bmw.x >> (4 * hi), wy_ = bmw.y >> (4 * hi); \
            _Pragma("unroll") for (int r = 0; r < 16; ++r) { const int cb_ = (r & 3) + 8 * (r >> 2); \
                const unsigned m0_ = (unsigned)__builtin_amdgcn_sbfe((int)wx_, cb_, 1), m1_ = (unsigned)__builtin_amdgcn_sbfe((int)wy_, cb_, 1); \
                C0[r] = __uint_as_float((m0_ & cvb_) | (~m0_ & 0xff800000u)); C1[r] = __uint_as_float((m1_ & cvb_) | (~m1_ & 0xff800000u)); } \
            PIN(C0); PIN(C1); } \
        else if (!NEGM && VAR != 0) { const float cv_ = bfar - mhat; _Pragma("unroll") for (int r = 0; r < 16; ++r) { C0[r] = cv_; C1[r] = cv_; } PIN(C0); PIN(C1); } \
        u32x2 bwn_ = {0u, 0u}; if (VAR == 2 && (t) + 1 < NT) bwn_ = *(const GAS u32x2*)(bmrow + 2 * ((t) + 1));     \
        _Pragma("unroll") for (int g_ = 0; g_ < NQK; ++g_) GAPA(C0, C1, P0, P1, g_); \
        l_reg += sacc; \
        if (VAR != 2 || near_) FIXUP(C0, C1, t, MASK, bmw); \
        bmw = bwn_; \
        float nm_ = TUPLE ? 0.f : ((near_ ? 0.f : bfar) - mhat);                                    \
        { const float rm = rowmax32f(C0, C1) + nm_; resc = false;                                    \
          if (__builtin_expect(__any(rm > A2_THR), 0)) { const float dl = __builtin_fmaxf(rm, 0.f); mhat += dl; fresc = __builtin_amdgcn_exp2f(-dl); l_reg *= fresc; resc = true; \
              if (TUPLE) { _Pragma("unroll") for (int r = 0; r < 16; ++r) { C0[r] -= dl; C1[r] -= dl; } FILLNEG(); } else nm_ -= dl; \
              if (VAR == 0) { const float cvn_ = bfar - mhat; _Pragma("unroll") for (int r = 0; r < 16; ++r) { P0[r] = cvn_; P1[r] = cvn_; } PIN(P0); PIN(P1); } } } \
        SBAR(); \
        _Pragma("unroll") for (int i_ = 0; i_ < 8; ++i_) { \
            if (GL && i_ >= 1 && i_ - 1 < ND0) { KLOAD(KSL, i_ - 1); SBAR(); } \
            { const int ks_ = i_ >> 1, db_ = i_ & 1, vi_ = 4 * db_ + ks_; \
              const bf16x8 pa_ = (ks_ == 0) ? PAF(0) : (ks_ == 1) ? PAF(1) : (ks_ == 2) ? PAF(2) : PAF(3); \
              oT[db_] = MFMA32(VFR(vi_), pa_, oT[db_]); } \
            if (TUPLE) { if (i_ < 4) EX4(C0, 4 * i_); else EX4(C1, 4 * (i_ - 4)); } else { if (i_ < 4) EX4N(C0, 4 * i_, nm_); else EX4N(C1, 4 * (i_ - 4), nm_); } \
            SBAR(); } \
    } while (0)
#define RESC() do { if (resc) { _Pragma("unroll") for (int r = 0; r < 16; ++r) { oT[0][r] *= fresc; oT[1][r] *= fresc; } } } while (0)
    for (int T2 = 0; 2 * T2 + 1 < NT; ++T2) {
        const int ta = 2 * T2 + 1, pcur = T2 & 1, pnxt = pcur ^ 1;
        if (ta + 3 < NT) DMA_K(ta + 3, 2 * pnxt);
        if (ta + 4 < NT) DMA_K(ta + 4, 2 * pnxt + 1);
        if (ta + 1 < NT) DMA_V(ta + 1, 2 * pnxt);
        if (ta + 2 < NT) DMA_V(ta + 2, 2 * pnxt + 1);
        STEP(pB0, pB1, pA0, pA1, ta, (ta >= NT - 4), (ta + 1 < NT), 2 * pcur, 2 * pcur); RESC();
        if (ta + 1 < NT) { STEP(pA0, pA1, pB0, pB1, ta + 1, (ta + 1 >= NT - 4), (ta + 2 < NT), 2 * pcur + 1, 2 * pcur + 1); RESC(); }
        wait_bar_n(0);
    }
    const int sl_cur = 2 * (((NT - 2) >> 1) & 1) + 1;
    { float sacc = 0.f;
#pragma unroll
      for (int r = 0; r < 16; ++r) sacc += pB0[r] + pB1[r];
      l_reg += sacc;
      pw0 = (u32x4){PKW(pB0, 0), PKW(pB0, 2), PKW(pB0, 4), PKW(pB0, 6)}; pw1 = (u32x4){PKW(pB0, 8), PKW(pB0, 10), PKW(pB0, 12), PKW(pB0, 14)};
      pw2 = (u32x4){PKW(pB1, 0), PKW(pB1, 2), PKW(pB1, 4), PKW(pB1, 6)}; pw3 = (u32x4){PKW(pB1, 8), PKW(pB1, 10), PKW(pB1, 12), PKW(pB1, 14)};
      const lds_cptr vp_ = vp0 + sl_cur * A2_VSLOT;
#pragma unroll
      for (int i = 0; i < 8; ++i) VRD(i);
#pragma unroll
      for (int ks = 0; ks < 4; ++ks) { const bf16x8 pa_ = (ks == 0) ? PAF(0) : (ks == 1) ? PAF(1) : (ks == 2) ? PAF(2) : PAF(3);
          oT[0] = MFMA32(VFR(ks), pa_, oT[0]); oT[1] = MFMA32(VFR(4 + ks), pa_, oT[1]); } }
    const float il = 1.0f / xhalf_sum(l_reg);
    bf16_t* mix = (bf16_t*)(ws + WS_MIX) + (size_t)qrow * DM + (VAR == 0 ? h * 64 : 512 + h * 64) + 4 * hi;
#pragma unroll
    for (int db = 0; db < 2; ++db)
#pragma unroll
        for (int g = 0; g < 4; ++g) { u32x2 w; w.x = pk2(oT[db][4 * g] * il, oT[db][4 * g + 1] * il); w.y = pk2(oT[db][4 * g + 2] * il, oT[db][4 * g + 3] * il); *(GAS u32x2*)(mix + 32 * db + 8 * g) = w; }
    wait_bar_n(0);
#undef DMA_K
#undef DMA_V
#undef KLOAD
#undef FILLNEG
#undef FIXUP
#undef NEARFILL
#undef PKW
#undef PAF
#undef VFR
#undef VRD
#undef EX4
#undef EX4N
#undef GAPA
#undef STEP
#undef RESC
}
__device__ __forceinline__ void attn_unit_pd(const P& p, int layer, int b, int h, int qb, LAS unsigned char* lds, int wave) {
    const int tid = phase_tid(wave), lane = tid & 63, r32 = lane & 31, hi = lane >> 5, wid = wave;
    const int q0 = qb * 256, NT = 4 * (qb + 1);
    const int qidx = q0 + wid * 32 + r32, qrow = b * S + qidx;
    const unsigned char* ws = p.ws; asm volatile("" : "+s"(ws));
    const unsigned lds0 = (unsigned)(uintptr_t)lds;
    const char* ksrc = (const char*)(ws + WS_KC) + ((size_t)(b * 4 + h) * NT64 * 8 + wid) * 1024 + lane * 16;
    const char* vsrc = (const char*)(ws + WS_VC) + (size_t)(b * 4 + h) * NT64 * 8192 + wid * 1024 + lane * 16;
    const unsigned kdst = lds0 + A2_KOFF + wid * 1024, vdst = lds0 + A2_VOFF + wid * 1024;
#define DMA_K(t, slot) glds16(ksrc + (size_t)(t) * 8192, (unsigned)__builtin_amdgcn_readfirstlane(kdst + (slot) * A2_KSLOT))
#define DMA_V(t, slot) glds16(vsrc + (size_t)(t) * 8192, (unsigned)__builtin_amdgcn_readfirstlane(vdst + (slot) * A2_VSLOT))
    DMA_K(0, 0); DMA_V(0, 0); DMA_K(1, 1);
    bf16x8 qf[4];
    { const bf16_t* qp = (const bf16_t*)(ws + WS_QC) + (size_t)qrow * 256 + h * 64 + 8 * hi;
#pragma unroll
      for (int i = 0; i < 4; ++i) qf[i] = *(const GAS bf16x8*)(qp + 16 * i); }
    LAS float* lutl = (LAS float*)(lds + A2_LUT);
    if (tid < 252) { int ri = tid - 64; ri = ri < 0 ? 0 : (ri > 128 ? 128 : ri); lutl[tid] = ((const float*)(ws + WS_MISC))[ri * 8 + 4 + h] - ((const float*)(ws + WS_MISC))[128 * 8 + 4 + h]; }
    const lds_cptr vp0 = (lds_cptr)lds + A2_VOFF + ((lane >> 4) & 1) * 32 + (lane & 3) * 8 + (4 * hi + ((lane & 15) >> 2)) * 64;
    const lds_cptr kp0 = (lds_cptr)lds + A2_KOFF + hi * 1024 + r32 * 16;
    float mhat0 = 0.f, mhat1 = 0.f, l0 = 0.f, l1 = 0.f;
    bool zr0 = true, zr1 = true;
    f32x16 oA[2], oB[2]; oA[0] = f32x16{}; oA[1] = f32x16{}; oB[0] = f32x16{}; oB[1] = f32x16{};
    f32x16 sc0, sc1; bf16x8 kfa[4], kfb[4]; s16x4 vlo[2], vhi[2];
    u32x4 pw0 = {0u, 0u, 0u, 0u}, pw1 = pw0, pw2 = pw0, pw3 = pw0;
    int sl_prev = 0, sl_cur = 0, sl_next = 1;
#define ROT() do { sl_prev = sl_cur; sl_cur = sl_next; sl_next = (sl_next == 2) ? 0 : sl_next + 1; } while (0)
#define KLD(KF, slot, c, d0) do { KF[2 * (d0)] = *(const LAS bf16x8*)(kp0 + (slot) * A2_KSLOT + (c) * 4096 + (d0) * 2048); KF[2 * (d0) + 1] = *(const LAS bf16x8*)(kp0 + (slot) * A2_KSLOT + (c) * 4096 + (d0) * 2048 + 512); } while (0)
#define CFILL(C0, C1, t, MH, NR) do { \
        if (NR) { \
            int bb_ = qidx - 64 * (t) - 4 * hi; bb_ = bb_ > 187 ? 187 : (bb_ < -5 ? -5 : bb_); const LAS float* lp_ = lutl + (bb_ + 5); const float mh_ = (MH); \
            _Pragma("unroll") for (int r = 0; r < 16; ++r) { const int off_ = 8 * (r >> 2) + (r & 3); C0[r] = lp_[59 - off_] - mh_; C1[r] = lp_[27 - off_] - mh_; if ((r & 3) == 3) { PIN(C0); PIN(C1); } } \
        } else { const float cv_ = -(MH); _Pragma("unroll") for (int r = 0; r < 16; ++r) { C0[r] = cv_; C1[r] = cv_; } PIN(C0); PIN(C1); } } while (0)
#define CMASK(C0, C1, t) do { int qd_ = qidx - 64 * (t) - 4 * hi; asm volatile("" : "+v"(qd_));     \
        _Pragma("unroll") for (int r = 0; r < 16; ++r) { const int kv = (r & 3) + 8 * (r >> 2); if (kv > qd_) C0[r] = NEG_INF; if (kv + 32 > qd_) C1[r] = NEG_INF; } } while (0)
#define PKW(P, i) cvtpk(P[i], P[i + 1])
#define PAF(k) __builtin_bit_cast(bf16x8, pw##k)
#define VFR(i) (bf16x8){vlo[i][0], vlo[i][1], vlo[i][2], vlo[i][3], vhi[i][0], vhi[i][1], vhi[i][2], vhi[i][3]}
#define VRDJ(j, i) do { vlo[j] = vtr(vp_ + (((i) >> 2) * 4096 + ((i) & 3) * 1024)); vhi[j] = vtr(vp_ + (((i) >> 2) * 4096 + ((i) & 3) * 1024 + 512)); } while (0)
#define EXS4(X, i) do { X[i] = __builtin_amdgcn_exp2f(X[i]); X[i + 1] = __builtin_amdgcn_exp2f(X[i + 1]); X[i + 2] = __builtin_amdgcn_exp2f(X[i + 2]); X[i + 3] = __builtin_amdgcn_exp2f(X[i + 3]); \
        sacc += X[i]; sacc += X[i + 1]; sacc += X[i + 2]; sacc += X[i + 3]; PIN(X); PIN(sacc); } while (0)
#define STEPD(KF, QB, t, MASK, MH, ZR, LC, OC, OP, VS, KFN, KS, KC, GL) do { SBAR(); \
        const lds_cptr vp_ = vp0 + (VS) * A2_VSLOT; float sacc = 0.f; \
        const bool nr_ = ((q0 + wid * 32) - (64 * (t) + 63)) < 113; \
        if (!nr_ && ZR) { sc0 = MFMA32(KF[0], qf[(QB)], f32x16{}); sc1 = MFMA32(KF[1], qf[(QB)], f32x16{}); }        \
        else { asm volatile(""); CFILL(sc0, sc1, t, MH, nr_); sc0 = MFMA32(KF[0], qf[(QB)], sc0); sc1 = MFMA32(KF[1], qf[(QB)], sc1); } \
        sc0 = MFMA32(KF[2], qf[(QB) + 1], sc0); sc1 = MFMA32(KF[3], qf[(QB) + 1], sc1); \
        VRDJ(0, 0); SBAR(); \
        if (MASK) CMASK(sc0, sc1, t); \
        { const float rm = rowmax32f(sc0, sc1); \
          if (__builtin_expect(__any(rm > A2_THR), 0)) { const float dl = __builtin_fmaxf(rm, 0.f); MH += dl; ZR = false; const float f_ = __builtin_amdgcn_exp2f(-dl); LC *= f_; \
              _Pragma("unroll") for (int r = 0; r < 16; ++r) { sc0[r] -= dl; sc1[r] -= dl; OC[0][r] *= f_; OC[1][r] *= f_; } } } \
        SBAR(); \
        _Pragma("unroll") for (int i_ = 0; i_ < 8; ++i_) { \
            if (i_ < 7) { VRDJ((i_ + 1) & 1, 4 * ((i_ + 1) & 1) + ((i_ + 1) >> 1)); }                   \
            if (GL && (i_ == 2 || i_ == 4)) { KLD(KFN, KS, KC, (i_ >> 1) - 1); } \
            SBAR(); \
            { const int ks_ = i_ >> 1, db_ = i_ & 1; \
              const bf16x8 pa_ = (ks_ == 0) ? PAF(0) : (ks_ == 1) ? PAF(1) : (ks_ == 2) ? PAF(2) : PAF(3); \
              OP[db_] = MFMA32(VFR(i_ & 1), pa_, OP[db_]); } \
            if (i_ < 4) EXS4(sc0, 4 * i_); else EXS4(sc1, 4 * (i_ - 4)); \
            if (i_ == 1) { pw0 = (u32x4){PKW(sc0, 0), PKW(sc0, 2), PKW(sc0, 4), PKW(sc0, 6)}; PIN(pw0); } \
            if (i_ == 3) { pw1 = (u32x4){PKW(sc0, 8), PKW(sc0, 10), PKW(sc0, 12), PKW(sc0, 14)}; PIN(pw1); } \
            if (i_ == 5) { pw2 = (u32x4){PKW(sc1, 0), PKW(sc1, 2), PKW(sc1, 4), PKW(sc1, 6)}; PIN(pw2); } \
            if (i_ == 7) { pw3 = (u32x4){PKW(sc1, 8), PKW(sc1, 10), PKW(sc1, 12), PKW(sc1, 14)}; PIN(pw3); } \
            SBAR(); } \
        LC += sacc; \
    } while (0)
    wait_bar_n(0);
    KLD(kfa, 0, 0, 0); KLD(kfa, 0, 0, 1);
    sl_prev = 2;
    for (int t = 0; t < NT; ++t) {
        if (t + 2 < NT) DMA_K(t + 2, sl_prev);
        if (t + 1 < NT) DMA_V(t + 1, sl_next);
        const bool mask_ = (t >= NT - 4);
        const int vs0_ = (t == 0) ? sl_cur : sl_prev;
        STEPD(kfa, 0, t, mask_, mhat0, zr0, l0, oA, oB, vs0_, kfb, sl_cur, 1, true);
        STEPD(kfb, 2, t, mask_, mhat1, zr1, l1, oB, oA, sl_cur, kfa, sl_next, 0, (t + 1 < NT));
        wait_bar_n(0); ROT();
    }
    { const lds_cptr vp_ = vp0 + sl_prev * A2_VSLOT;
#pragma unroll
      for (int ks = 0; ks < 4; ++ks) { const bf16x8 pa_ = (ks == 0) ? PAF(0) : (ks == 1) ? PAF(1) : (ks == 2) ? PAF(2) : PAF(3);
          VRDJ(0, ks); VRDJ(1, 4 + ks); oB[0] = MFMA32(VFR(0), pa_, oB[0]); oB[1] = MFMA32(VFR(1), pa_, oB[1]); SBAR(); } }
    {
        const float* lp = p.diff_lambda + layer * 128; float d01 = 0.f, d23 = 0.f;
        for (int i = 0; i < 32; ++i) { d01 += lp[i] * lp[32 + i]; d23 += lp[64 + i] * lp[96 + i]; }
        const float lam_init = lam_init_of(layer), lam = expf(d01) - expf(d23) + lam_init;
        const float i0 = 1.0f / xhalf_sum(l0), i1 = lam / xhalf_sum(l1);
        float ss = 0.f;
#pragma unroll
        for (int db = 0; db < 2; ++db)
#pragma unroll
            for (int r = 0; r < 16; ++r) { const float v = oA[db][r] * i0 - oB[db][r] * i1; oA[db][r] = v; ss += v * v; }
        ss = xhalf_sum(ss);
        const float rsn = 1.0f / sqrtf(ss / 64.f + EPS) * (1.f - lam_init);
        const float* g = p.diff_subln + layer * 64;
        bf16_t* mix = (bf16_t*)(ws + WS_MIX) + (size_t)qrow * DM + 768 + h * 64 + 4 * hi;
#pragma unroll
        for (int db = 0; db < 2; ++db)
#pragma unroll
            for (int gg = 0; gg < 4; ++gg) { float o4[4];
#pragma unroll
                for (int i = 0; i < 4; ++i) o4[i] = oA[db][4 * gg + i] * rsn * g[32 * db + 8 * gg + 4 * hi + i];
                u32x2 w; w.x = pk2(o4[0], o4[1]); w.y = pk2(o4[2], o4[3]); *(GAS u32x2*)(mix + 32 * db + 8 * gg) = w; }
    }
    wait_bar_n(0);
#undef DMA_K
#undef DMA_V
#undef ROT
#undef KLD
#undef CFILL
#undef CMASK
#undef PKW
#undef PAF
#undef VFR
#undef EXS4
#undef VRDJ
#undef STEPD
}
constexpr int SEL_KPITCH = 4104;
constexpr int SEL_HSTRIDE = 260;
constexpr int SEL_HIST = 16 * SEL_KPITCH * 2;
__device__ __forceinline__ unsigned score_key(float s) {
    const _Float16 hf = (_Float16)s; unsigned u = (unsigned)__builtin_bit_cast(unsigned short, hf);
    if (u == 0x8000u) u = 0u;
    return (u & 0x8000u) ? (~u & 0xffffu) : (u | 0x8000u);
}
__device__ __forceinline__ unsigned wave_scan_incl(unsigned v) {
#define DPP_ADD(ctrl, rm) v += (unsigned)__builtin_amdgcn_update_dpp(0, (int)v, ctrl, rm, 0xf, false)
    DPP_ADD(0x111, 0xf); DPP_ADD(0x112, 0xf); DPP_ADD(0x114, 0xf); DPP_ADD(0x118, 0xf); DPP_ADD(0x142, 0xa); DPP_ADD(0x143, 0xc);
#undef DPP_ADD
    return v;
}
__device__ __forceinline__ void find_bin2(LAS unsigned* hist, int lane, unsigned tgtA, unsigned tgtB, unsigned& binA, unsigned& aboveA, unsigned& binB, unsigned& aboveB) {
    const u32x4 c = *(LAS u32x4*)(hist + 4 * lane);
    const unsigned inc = wave_scan_incl(c.x + c.y + c.z + c.w);
    const unsigned all = (unsigned)__builtin_amdgcn_readlane((int)inc, 63);
    unsigned ab = all - inc;
    unsigned abA = ab & 0xffffu, abB = ab >> 16;
    unsigned fA = 0u, fbA = 0u, faA = 0u, fB = 0u, fbB = 0u, faB = 0u;
    const unsigned cc[4] = {c.x, c.y, c.z, c.w};
#pragma unroll
    for (int i = 3; i >= 0; --i) { const unsigned a = cc[i] & 0xffffu, bq = cc[i] >> 16;
        if (!fA && abA + a >= tgtA) { fA = 1u; fbA = 4 * lane + i; faA = abA; } abA += a;
        if (!fB && abB + bq >= tgtB) { fB = 1u; fbB = 4 * lane + i; faB = abB; } abB += bq; }
    const unsigned long long balA = __ballot(fA != 0u), balB = __ballot(fB != 0u);
    const int srcA = __builtin_amdgcn_readfirstlane(63 - __builtin_clzll(balA | 1ull)), srcB = __builtin_amdgcn_readfirstlane(63 - __builtin_clzll(balB | 1ull));
    binA = (unsigned)__builtin_amdgcn_readlane((int)fbA, srcA); aboveA = (unsigned)__builtin_amdgcn_readlane((int)faA, srcA);
    binB = (unsigned)__builtin_amdgcn_readlane((int)fbB, srcB); aboveB = (unsigned)__builtin_amdgcn_readlane((int)faB, srcB);
}
typedef unsigned short u16x2 __attribute__((ext_vector_type(2)));
__device__ __forceinline__ unsigned fold8(unsigned a, unsigned b_, unsigned c, unsigned d) {
    const unsigned x = a + (b_ << 2) + (c << 4) + (d << 6); return (x & 0x55u) | ((x >> 15) & 0xaau); }
__device__ __forceinline__ void group_masks(LAS const unsigned short* kq, int lane, unsigned thr, unsigned long long& gtm, unsigned long long& eqm) {
    gtm = 0ull; eqm = 0ull;
    const unsigned t2 = thr | (thr << 16); const u16x2 tv = __builtin_bit_cast(u16x2, t2), one = {1, 1};
#pragma unroll
    for (int i = 0; i < 8; ++i) { const int ch = (i + lane) & 7;
        const u32x4 v = *(LAS const u32x4*)(kq + 8 * ch);
        unsigned g[4], n[4]; const unsigned w[4] = {v.x, v.y, v.z, v.w};
#pragma unroll
        for (int u = 0; u < 4; ++u) { const u16x2 k = __builtin_bit_cast(u16x2, w[u]);
            g[u] = __builtin_bit_cast(unsigned, __builtin_elementwise_min(__builtin_elementwise_sub_sat(k, tv), one));
            n[u] = __builtin_bit_cast(unsigned, __builtin_elementwise_min(__builtin_bit_cast(u16x2, w[u] ^ t2), one)); }
        const unsigned g8 = fold8(g[0], g[1], g[2], g[3]), e8 = fold8(n[0], n[1], n[2], n[3]) ^ 0xffu;
        gtm |= (unsigned long long)g8 << (8 * ch); eqm |= (unsigned long long)e8 << (8 * ch); }
}
__device__ __forceinline__ void select_unit(const P& p, int b, int qblk, LAS unsigned char* lds, int wave_id) {
    const int tid = phase_tid(wave_id), lane = tid & 63, wave = wave_id;
    const int q0 = qblk * 16, row0 = b * S + q0, nk = q0 + 16;
    LAS unsigned short* keys = (LAS unsigned short*)lds;
    LAS unsigned* hist0 = (LAS unsigned*)(lds + SEL_HIST);
    LAS unsigned* hist = hist0 + wave * SEL_HSTRIDE;
    const unsigned char* ws = p.ws; asm volatile("" : "+s"(ws));
    unsigned z0 = 0u; asm volatile("" : "+v"(z0));
#ifndef PROBE
#define PROBE 0
#endif
    for (int rep_ = 0; rep_ < (PROBE == 11 ? 2 : 1); ++rep_) {
    *(LAS u32x4*)(hist + 4 * lane) = (u32x4){z0, z0, z0, z0};
    __syncthreads();
    {
        const int qc = lane & 15, kg = lane >> 4;
        const bf16_t* QI = (const bf16_t*)(ws + WS_QI) + (size_t)(row0 + qc) * 256 + 8 * kg;
        bf16x8 qf[8];
#pragma unroll
        for (int h = 0; h < 8; ++h) qf[h] = *(const GAS bf16x8*)(QI + h * 32);
        const float* WI = (const float*)(ws + WS_WI) + (size_t)(row0 + qc) * 8;
        const f32x4 w0 = *(const GAS f32x4*)WI, w1 = *(const GAS f32x4*)(WI + 4);
        const float w[8] = {0.5f * w0.x, 0.5f * w0.y, 0.5f * w0.z, 0.5f * w0.w, 0.5f * w1.x, 0.5f * w1.y, 0.5f * w1.z, 0.5f * w1.w};
        bf16x8 qlh, qll;
        {
            float ql[8];
#pragma unroll
            for (int e = 0; e < 8; ++e) ql[e] = 0.f;
#pragma unroll
            for (int h = 0; h < 8; ++h) { float t8[8]; unpk8(__builtin_bit_cast(u32x4, qf[h]), t8);
#pragma unroll
                for (int e = 0; e < 8; ++e) ql[e] += w[h] * t8[e]; }
            const u32x4 hi4 = pk8(ql); float hf[8], lo[8]; unpk8(hi4, hf);
#pragma unroll
            for (int e = 0; e < 8; ++e) lo[e] = ql[e] - hf[e];
            qlh = __builtin_bit_cast(bf16x8, hi4); qll = __builtin_bit_cast(bf16x8, pk8(lo));
        }
        const bf16_t* KI = (const bf16_t*)(ws + WS_KI) + (size_t)(b * S + qc) * 32 + 8 * kg;
        LAS unsigned* hq = hist0 + (qc >> 1) * SEL_HSTRIDE; const unsigned hinc = (qc & 1) ? 0x10000u : 1u;
        const int nch = nk / 16;
        bf16x8 ka = *(const GAS bf16x8*)(KI + (size_t)(wave < nch ? wave : 0) * 512), kb = *(const GAS bf16x8*)(KI + (size_t)(wave + 8 < nch ? wave + 8 : 0) * 512);
        for (int c = wave; c < nch; c += 16) {
            const int c2 = c + 16, c3 = c + 24;
            const bf16x8 na = *(const GAS bf16x8*)(KI + (size_t)(c2 < nch ? c2 : 0) * 512), nb = *(const GAS bf16x8*)(KI + (size_t)(c3 < nch ? c3 : 0) * 512);
#pragma unroll
            for (int u = 0; u < 2; ++u) {
                const int cc = c + 8 * u; if (cc >= nch) break;
                const bf16x8 kf = u ? kb : ka;
                f32x4 sc = MFMA16(kf, qll, MFMA16(kf, qlh, ((f32x4){0.f, 0.f, 0.f, 0.f})));
                f32x4 dh[8];
#pragma unroll
                for (int h = 0; h < 8; ++h) dh[h] = MFMA16(kf, qf[h], ((f32x4){0.f, 0.f, 0.f, 0.f}));
                __builtin_amdgcn_sched_barrier(0);
#pragma unroll
                for (int h = 0; h < 8; ++h)
#pragma unroll
                    for (int i = 0; i < 4; ++i) sc[i] = __builtin_fmaf(w[h], __builtin_fabsf(dh[h][i]), sc[i]);
                const int kbase = 16 * cc + 4 * kg;
                typedef __fp16 h2 __attribute__((ext_vector_type(2)));
                const h2 p01 = __builtin_amdgcn_cvt_pkrtz(sc[0], sc[1]), p23 = __builtin_amdgcn_cvt_pkrtz(sc[2], sc[3]);
                unsigned x0 = __builtin_bit_cast(unsigned, p01), x1 = __builtin_bit_cast(unsigned, p23);
                { typedef short s16x2 __attribute__((ext_vector_type(2)));
                  const unsigned m0 = __builtin_bit_cast(unsigned, __builtin_bit_cast(s16x2, x0) >> 15), m1 = __builtin_bit_cast(unsigned, __builtin_bit_cast(s16x2, x1) >> 15);
                  x0 ^= (m0 | 0x80008000u); x1 ^= (m1 | 0x80008000u); }
                if (cc == nch - 1) {
                    asm volatile("");
                    const int lim = q0 + qc - kbase;
                    if (lim < 0) x0 = 0u; else if (lim < 1) x0 &= 0x0000ffffu;
                    if (lim < 2) x1 = 0u; else if (lim < 3) x1 &= 0x0000ffffu;
                }
                u32x2 wv; wv.x = x0; wv.y = x1;
                *(LAS u32x2*)(keys + qc * SEL_KPITCH + kbase) = wv;
                __hip_atomic_fetch_add(hq + ((x0 >> 8) & 0xffu), hinc, __ATOMIC_RELAXED, __HIP_MEMORY_SCOPE_WORKGROUP); __hip_atomic_fetch_add(hq + (x0 >> 24), hinc, __ATOMIC_RELAXED, __HIP_MEMORY_SCOPE_WORKGROUP);
                __hip_atomic_fetch_add(hq + ((x1 >> 8) & 0xffu), hinc, __ATOMIC_RELAXED, __HIP_MEMORY_SCOPE_WORKGROUP); __hip_atomic_fetch_add(hq + (x1 >> 24), hinc, __ATOMIC_RELAXED, __HIP_MEMORY_SCOPE_WORKGROUP);
            }
            ka = na; kb = nb;
        }
    }
    __syncthreads();
    }
    unsigned* BM = (unsigned*)(ws + WS_BM);
    {
        const int qa = 2 * wave, tA = q0 + qa, tB = tA + 1, nA = tA + 1, nB = tB + 1;
        LAS unsigned short* kqA = keys + qa * SEL_KPITCH; LAS unsigned short* kqB = kqA + SEL_KPITCH;
        unsigned thrA = 0u, thrB = 0u, ntA = 0u, ntB = 0u;
        if (nB > NSEL) {
            unsigned b1A, a1A, b1B, a1B; find_bin2(hist, lane, (unsigned)NSEL, (unsigned)NSEL, b1A, a1A, b1B, a1B);
            const unsigned r1A = (unsigned)NSEL - a1A, r1B = (unsigned)NSEL - a1B;
            asm volatile("s_waitcnt lgkmcnt(0)" ::: "memory");
            *(LAS u32x4*)(hist + 4 * lane) = (u32x4){z0, z0, z0, z0};
            asm volatile("s_waitcnt lgkmcnt(0)" ::: "memory");
            for (int i = 4 * lane; i < nk; i += 256) { const u32x2 kA2 = *(LAS u32x2*)(kqA + i), kB2 = *(LAS u32x2*)(kqB + i);
                const unsigned eA[4] = {kA2.x & 0xffffu, kA2.x >> 16, kA2.y & 0xffffu, kA2.y >> 16}, eB[4] = {kB2.x & 0xffffu, kB2.x >> 16, kB2.y & 0xffffu, kB2.y >> 16};
#pragma unroll
                for (int u = 0; u < 4; ++u) { if ((eA[u] >> 8) == b1A) __hip_atomic_fetch_add(hist + (eA[u] & 0xffu), 1u, __ATOMIC_RELAXED, __HIP_MEMORY_SCOPE_WORKGROUP);
                                              if ((eB[u] >> 8) == b1B) __hip_atomic_fetch_add(hist + (eB[u] & 0xffu), 0x10000u, __ATOMIC_RELAXED, __HIP_MEMORY_SCOPE_WORKGROUP); } }
            asm volatile("s_waitcnt lgkmcnt(0)" ::: "memory");
            unsigned b2A, a2A, b2B, a2B; find_bin2(hist, lane, r1A, r1B, b2A, a2A, b2B, a2B);
            thrA = (b1A << 8) | b2A; ntA = r1A - a2A; thrB = (b1B << 8) | b2B; ntB = r1B - a2B;
            asm volatile("s_waitcnt lgkmcnt(0)" ::: "memory");
        }
        const int gbase = 64 * lane;
        unsigned long long mA, mB;
        { const int cA = tA + 1 - gbase, cB = tB + 1 - gbase;
          mA = cA >= 64 ? ~0ull : (cA > 0 ? ((1ull << cA) - 1ull) : 0ull); mB = cB >= 64 ? ~0ull : (cB > 0 ? ((1ull << cB) - 1ull) : 0ull); }
        if (nB > NSEL) {
            unsigned long long gA = 0ull, eA = 0ull, gB = 0ull, eB = 0ull;
            if (gbase < nk) { group_masks(kqA + gbase, lane, thrA, gA, eA); group_masks(kqB + gbase, lane, thrB, gB, eB);
                const int vb = nk - gbase; if (vb < 64) { const unsigned long long vm = (1ull << vb) - 1ull; gA &= vm; eA &= vm; gB &= vm; eB &= vm; } }
            int cntA = __builtin_popcountll(eA), cntB = __builtin_popcountll(eB);
            const unsigned inc = wave_scan_incl((unsigned)cntA | ((unsigned)cntB << 16));
            int keepA = (int)ntA - ((int)(inc & 0xffffu) - cntA), keepB = (int)ntB - ((int)(inc >> 16) - cntB);
            keepA = keepA < 0 ? 0 : keepA; keepB = keepB < 0 ? 0 : keepB;
            while (cntA > keepA) { eA &= ~(1ull << (63 - __builtin_clzll(eA))); --cntA; }
            while (cntB > keepB) { eB &= ~(1ull << (63 - __builtin_clzll(eB))); --cntB; }
            if (nA > NSEL) mA = gA | eA;
            mB = gB | eB;
        }
        *(GAS unsigned long long*)(BM + (size_t)(row0 + qa) * 128 + 2 * lane) = mA;
        *(GAS unsigned long long*)(BM + (size_t)(row0 + qa + 1) * 128 + 2 * lane) = mB;
    }
    __syncthreads();
}
#ifdef NO_DIFF_P
#define U_DIFF_P(x)
#else
#define U_DIFF_P(x) x
#endif
#ifdef NO_DIFF_S
#define U_DIFF_S(x)
#else
#define U_DIFF_S(x) x
#endif
#ifdef NO_DSA_P
#define U_DSA_P(x)
#else
#define U_DSA_P(x) x
#endif
#ifdef NO_DSA_S
#define U_DSA_S(x)
#else
#define U_DSA_S(x) x
#endif
#ifdef NO_MLA
#define U_MLA(x)
#else
#define U_MLA(x) x
#endif
#ifdef NO_SEL
#define U_SEL(x)
#else
#define U_SEL(x) x
#endif
__device__ __forceinline__ int wq_next(unsigned* ctr, volatile LAS unsigned* slot, int wave) {
    const int tid = phase_tid(wave);
    __syncthreads();
    if (tid == 0) *slot = __hip_atomic_fetch_add(ctr, 1u, __ATOMIC_RELAXED, __HIP_MEMORY_SCOPE_AGENT);
    __syncthreads();
    return (int)*slot;
}
__device__ __forceinline__ void wq_request(unsigned* ctr, volatile LAS unsigned* slot, int wave) {
    if (phase_tid(wave) == 0) *slot = __hip_atomic_fetch_add(ctr, 1u, __ATOMIC_RELAXED, __HIP_MEMORY_SCOPE_AGENT);
}
__device__ __forceinline__ int wq_take(volatile LAS unsigned* slot) { __syncthreads(); return (int)*slot; }
__device__ __forceinline__ void phase_b_extra(const P& p, int layer, LAS unsigned char* lds, volatile LAS unsigned* MISC, int wave, int kinds = 15, int rep = 0) {
    unsigned* ctr = (unsigned*)(p.ws + WS_CTL) + CW_WQ + 64 * (2 * layer + 4 * rep);
    const unsigned* aff = (const unsigned*)(p.ws + WS_CTL) + CW_AFF;
    const int NCONV = (layer == 0 && (kinds & 8)) ? 256 : 0;
    constexpr int I_DIFF = 256, I_T8 = I_DIFF + 64, I_QUP = I_T8 + 192, I_KVUP = I_QUP + 256;
    const int I_CONV = I_KVUP + NCONV, I_SEL = I_CONV + 512;
    int it = 0;
    for (int idx = wq_next(ctr, MISC + 16, wave); idx < I_SEL; ++it) {
        if (idx < I_DIFF) { const int qb = 15 - (idx >> 4), r = idx & 15;
            if (kinds & 1) { if (aff[r >> 2] == 0u) { U_DIFF_P(attn_unit_pd(p, layer, r >> 2, r & 3, qb, lds, wave)); } else { U_DIFF_S(attn_unit<1>(p, layer, r >> 2, r & 3, qb, lds, wave)); } } }
        else if (idx < I_T8) { if (kinds & 4) run_gemm_unit(lds, p, layer, 2, idx - I_DIFF, 0, wave); }
        else if (idx < I_QUP) { const int u = idx - I_T8; if (kinds & 4) run_gemm_unit(lds, p, layer, 0, u / 3, u % 3, wave); }
        else if (idx < I_KVUP) { const int u = idx - I_QUP; if (kinds & 4) run_gemm_unit(lds, p, layer, 1, u >> 2, u & 3, wave); }
        else if (idx < I_CONV) { prep_w_range(p, 3, 12, idx - I_KVUP, 256, (float*)lds, phase_tid(wave)); }
        else { const int j = idx - I_CONV, qb = 15 - (j >> 5), s = j & 31;
            if (kinds & 2) { U_SEL(select_unit(p, s >> 3, qb * 16 + 2 * (s & 7), lds, wave)); U_SEL(select_unit(p, s >> 3, qb * 16 + 2 * (s & 7) + 1, lds, wave)); } }
        idx = wq_next(ctr, MISC + 16, wave);
    }
}
__device__ __forceinline__ void phase_c(const P& p, int layer, LAS unsigned char* lds, volatile LAS unsigned* MISC, int wave, int kinds = 3, int rep = 0) {
    unsigned* ctr = (unsigned*)(p.ws + WS_CTL) + CW_WQ + 64 * (2 * layer + 1 + 4 * rep);
    const unsigned* aff = (const unsigned*)(p.ws + WS_CTL) + CW_AFF;
    int it = 0;
    for (int idx = wq_next(ctr, MISC + 16, wave); idx < 16 * 48; ++it) {
        const int lvl = idx / 48, r = idx % 48, qb = 15 - lvl;
        if (r < 32) { if (kinds & 1) { U_MLA(attn_unit_q<0>(p, layer, r >> 3, r & 7, qb, lds, wave)); } }
        else if (kinds & 2) { const int s = r - 32; if (aff[s >> 2] == 0u) { U_DSA_P(attn_unit_q<2>(p, layer, s >> 2, s & 3, qb, lds, wave)); } else { U_DSA_S(attn_unit<2>(p, layer, s >> 2, s & 3, qb, lds, wave)); } }
        idx = wq_next(ctr, MISC + 16, wave);
    }
}
constexpr int NPH = 13;
struct Args { P p; int ph_lo, ph_hi; };
__global__ void __launch_bounds__(NWAVES * 64, 2) fwd(Args a) {
    extern __shared__ __attribute__((aligned(16))) unsigned char lds_raw[];
    LAS unsigned char* lds = (LAS unsigned char*)lds_raw;
    const P& p = a.p;
    const int wave = __builtin_amdgcn_readfirstlane(threadIdx.x >> 6);
    volatile LAS unsigned* MISC = (volatile LAS unsigned*)(lds + MISC_OFF);
    { const int tid = phase_tid(wave);
    for (int u = tid; u < (LDS_BYTES - LDSCTL_OFF) / 4; u += NWAVES * 64) ((LAS unsigned*)(lds + LDSCTL_OFF))[u] = 0u; }
    __syncthreads();
    const int lo = a.ph_lo, hi = a.ph_hi;
    unsigned* ctl = (unsigned*)(p.ws + WS_CTL);
    XcdBarrier bar; bar.bar = ctl + CW_BAR; bar.x = 0; bar.st = nullptr;
    if (hi - lo > 1) bar = xcd_barrier_post(ctl + CW_BAR, MISC + 8, phase_tid(wave));
#define IN(k) (lo <= (k) && (k) < hi)
#ifndef PROBE
#define PROBE 0
#endif
#define PBAR() xcd_barrier(bar, phase_tid(wave))
#define LOPQ int ll = l; asm volatile("" : "+s"(ll))
#define SEAM(k) do { if (IN(k) && IN((k) + 1)) xcd_barrier(bar, phase_tid(wave)); } while (0)

    for (int rep = 0; rep < (PROBE == 1 ? 2 : 1); ++rep) { if (rep) PBAR();
    if (IN(0)) {
        const int tid = phase_tid(wave), lane = tid & 63;
        float* scr = (float*)lds_raw;
        prep_w_range(p, 0, 3, (int)blockIdx.x, (int)gridDim.x, scr, tid);
        const int gw = blockIdx.x * NWAVES + wave, ngw = gridDim.x * NWAVES;
        for (int r = gw; r < T; r += ngw) prep_x_row(p, r, lane);
        for (int i = blockIdx.x * (NWAVES * 64) + tid; i < T * 16; i += gridDim.x * NWAVES * 64) prep_rope(p, i);
        for (int i = blockIdx.x * (NWAVES * 64) + tid; i < T; i += gridDim.x * NWAVES * 64) { const int bb = i >> 12; if ((PROBE == 30) || p.pos[i] - p.pos[bb * S] != (i & (S - 1))) atomicOr((unsigned*)(p.ws + WS_CTL) + CW_AFF + bb, 1u); }
        if (blockIdx.x == 0) for (int i = tid; i < 129 * 8; i += NWAVES * 64) prep_lut(p, i);
        if (wave == 0) {
            for (int blk = blockIdx.x; blk < T / 64; blk += gridDim.x) {
                const int v = p.pos[blk * 64 + lane]; int mx = v, mn = v;
#pragma unroll
                for (int o = 1; o < 32; o <<= 1) { mx = max(mx, __shfl_xor(mx, o)); mn = min(mn, __shfl_xor(mn, o)); }
                const int mx2 = max(mx, __shfl_xor(mx, 32));
                if ((lane & 31) == 0) ((int*)(p.ws + WS_MISC + MISC_PMIN32))[blk * 2 + (lane >> 5)] = mn;
                if (lane == 0) ((int*)(p.ws + WS_MISC + MISC_PMAX64))[blk] = mx2;
            }
        }
    }
    }
    if (PROBE == 13) { for (int i = 0; i < 10; ++i) PBAR(); }
    SEAM(0);
    for (int l = 0; l < DEPTH; ++l) {
        const int pb = 1 + 6 * l;
        for (int rep = 0; rep < (PROBE == 2 ? 2 : 1); ++rep) { if (rep) PBAR(); if (IN(pb + 0)) { LOPQ; run_gemm<EPI_IN>(lds, p, ll, WS_XB, WS_WIN + ll * SZ_WIN, T, 2048, DM, wave); } }
        if (PROBE == 22 && IN(pb + 0)) { PBAR(); LOPQ; run_gemm_none(lds, p, WS_XB, WS_WIN + ll * SZ_WIN, T, 2048, DM, wave); }
        SEAM(pb + 0);
        if (IN(pb + 1)) {
            { LOPQ; phase_b_extra(p, ll, lds, MISC, wave); }
            if (PROBE == 20) { PBAR(); LOPQ; phase_b_extra(p, ll, lds, MISC, wave, 7, 1); }
            if (PROBE == 24) { PBAR(); LOPQ; phase_b_extra(p, ll, lds, MISC, wave, 3, 1); }
            if (PROBE == 25) { PBAR(); LOPQ; phase_b_extra(p, ll, lds, MISC, wave, 5, 1); }
            if (PROBE == 3) { PBAR(); LOPQ; phase_b_extra(p, ll, lds, MISC, wave, 4, 1); }
            if (PROBE == 4) { PBAR(); LOPQ; phase_b_extra(p, ll, lds, MISC, wave, 1, 1); }
            if (PROBE == 9) { PBAR(); LOPQ; phase_b_extra(p, ll, lds, MISC, wave, 2, 1); }
        }
        SEAM(pb + 1);
        if (IN(pb + 2)) {
            { LOPQ; phase_c(p, ll, lds, MISC, wave); }
            if (PROBE == 21) { PBAR(); LOPQ; phase_c(p, ll, lds, MISC, wave, 3, 1); }
            if (PROBE == 5) { PBAR(); LOPQ; phase_c(p, ll, lds, MISC, wave, 1, 1); }
            if (PROBE == 10) { PBAR(); LOPQ; phase_c(p, ll, lds, MISC, wave, 2, 1); }
        }
        SEAM(pb + 2);
        for (int rep = 0; rep < ((PROBE == 6 && l == 0) ? 2 : 1); ++rep) { if (rep) PBAR(); if (IN(pb + 3)) { LOPQ; run_gemm<EPI_OUT>(lds, p, ll, WS_MIX, WS_WOUT + ll * SZ_WOUT, T, DM, DM, wave); } }
        SEAM(pb + 3);
        for (int rep = 0; rep < (PROBE == 7 ? 2 : 1); ++rep) { if (rep) PBAR(); if (IN(pb + 4)) { LOPQ; run_gemm<EPI_UP>(lds, p, ll, WS_XB, WS_WUP + ll * SZ_WUP, T, DFF, DM, wave); } }
        SEAM(pb + 4);
        if (IN(pb + 5)) { LOPQ; if (ll + 1 < DEPTH || gridDim.x != 256) run_gemm<EPI_DOWN>(lds, p, ll, WS_U, WS_WDN + ll * SZ_WDN, T, DM, DFF, wave); else run_gemm_final(lds, p, WS_U, WS_WDN + ll * SZ_WDN, wave); }
        SEAM(pb + 5);
    }
    if (gridDim.x != 256 && lo <= 12 && 12 < hi) { xcd_barrier(bar, phase_tid(wave));
        const int lane = phase_tid(wave) & 63;
        const int gw = blockIdx.x * NWAVES + wave, ngw = gridDim.x * NWAVES;
        for (int row = gw; row < T; row += ngw) {
            float s = ((const float*)(p.ws + WS_RSA))[(size_t)row * 32 + (lane & 31)];
#pragma unroll
            for (int o = 1; o < 32; o <<= 1) s += __shfl_xor(s, o);
            const float rs = 1.0f / sqrtf(s / (float)DM + EPS);
            const bf16_t* xb = (const bf16_t*)(p.ws + WS_XB) + (size_t)row * DM + lane * 8;
            float* o = p.out + (size_t)row * DM + lane * 8;
#pragma unroll
            for (int j = 0; j < 2; ++j) { float v[8]; unpk8(*(const GAS u32x4*)(xb + 512 * j), v);
                const f32x4 g0 = *(const GAS f32x4*)(p.norm_final + lane * 8 + 512 * j), g1 = *(const GAS f32x4*)(p.norm_final + lane * 8 + 512 * j + 4);
                *(GAS f32x4*)(o + 512 * j) = (f32x4){v[0] * rs * g0.x, v[1] * rs * g0.y, v[2] * rs * g0.z, v[3] * rs * g0.w};
                *(GAS f32x4*)(o + 512 * j + 4) = (f32x4){v[4] * rs * g1.x, v[5] * rs * g1.y, v[6] * rs * g1.z, v[7] * rs * g1.w}; }
        }
    }
#undef IN
#undef SEAM
}
static P make_params(void* const* d_in, void* d_out, void* d_ws) {
    P p{};
    p.x = (const float*)d_in[0]; p.pos = (const int*)d_in[1]; p.rel_bias = (const float*)d_in[2]; p.norm_attn = (const float*)d_in[3]; p.w_in = (const float*)d_in[4];
    p.q_norm = (const float*)d_in[5]; p.w_uq = (const float*)d_in[6]; p.kv_norm = (const float*)d_in[7]; p.w_ukv = (const float*)d_in[8]; p.diff_lambda = (const float*)d_in[9];
    p.diff_subln = (const float*)d_in[10]; p.w_out = (const float*)d_in[11]; p.norm_mlp = (const float*)d_in[12]; p.w_up = (const float*)d_in[13]; p.w_down = (const float*)d_in[14];
    p.norm_final = (const float*)d_in[15]; p.out = (float*)d_out; p.ws = (unsigned char*)d_ws;
    return p;
}
extern "C" void kernel_launch(void* const* d_in, const int* in_sizes, int n_in, void* d_out, int out_size, void* d_ws, size_t ws_size, hipStream_t stream) {
    static int grid = 0;
    if (!grid) {
        if (n_in != 16 || out_size != T * DM || ws_size < 256 * MiB) { fprintf(stderr, "kernel_launch: unexpected shapes n_in %d out %d ws %zu\n", n_in, out_size, ws_size); grid = -1; return; }
        if (hipFuncSetAttribute((const void*)fwd, hipFuncAttributeMaxDynamicSharedMemorySize, LDS_BYTES) != hipSuccess) { fprintf(stderr, "kernel_launch: hipFuncSetAttribute failed\n"); grid = -1; return; }
        int dev = 0, cus = 0, per_cu = 0;
        if (hipGetDevice(&dev) != hipSuccess || hipDeviceGetAttribute(&cus, hipDeviceAttributeMultiprocessorCount, dev) != hipSuccess) { grid = -1; return; }
        if (hipOccupancyMaxActiveBlocksPerMultiprocessor(&per_cu, (const void*)fwd, NWAVES * 64, LDS_BYTES) != hipSuccess || per_cu < 1) fprintf(stderr, "kernel_launch: occupancy query says %d\n", per_cu);
        (void)hipGetLastError();
        grid = cus;
    }
    if (grid < 0) return;
    if (hipMemsetAsync((char*)d_ws + WS_CTL, 0, CTL_ZERO_BYTES, stream) != hipSuccess) return;
    Args a{}; a.p = make_params(d_in, d_out, d_ws); a.ph_lo = 0; a.ph_hi = NPH;
    hipLaunchKernelGGL(fwd, dim3(grid), dim3(NWAVES * 64), LDS_BYTES, stream, a);
}
```

```cpp
#include <hip/hip_runtime.h>
#define PROBE 0
#include <stdint.h>
#include <stdio.h>

constexpr int NB = 4, S = 4096, T = NB * S, DM = 1024, DEPTH = 2;
constexpr int H_MLA = 8, H_DSA = 4, H_IDX = 8, D_IDX = 32, H_DIFF = 4;
constexpr int Q_LORA = 384, KV_LORA = 256;
constexpr int N_IN = 2120, N_INP = 2304, DFF = 4096, NQ_UP = 768, NKV_UP = 1024;
constexpr int NSEL = 256;
constexpr float EPS = 1e-6f, LOG2E = 1.4426950408889634f;
constexpr int NT64 = S / 64;

#define GAS __attribute__((address_space(1)))
typedef unsigned short bf16_t;
typedef short bf16x8 __attribute__((ext_vector_type(8)));
typedef float f32x4 __attribute__((ext_vector_type(4)));
typedef float f32x16 __attribute__((ext_vector_type(16)));
typedef unsigned u32x4 __attribute__((ext_vector_type(4)));
typedef unsigned u32x2 __attribute__((ext_vector_type(2)));

constexpr size_t MiB = 1u << 20;
constexpr size_t WS_CTL = 0;
constexpr size_t WS_RSA = 1 * MiB;
constexpr size_t WS_RSB = 3 * MiB;
constexpr size_t WS_RSCQ = 5 * MiB;
constexpr size_t WS_RSCKV = 6 * MiB;
constexpr size_t WS_MISC = 6 * MiB + 512 * 1024;
constexpr size_t WS_W = 7 * MiB;
constexpr size_t SZ_WIN = (size_t)N_INP * DM * 2, SZ_WUQ = (size_t)NQ_UP * Q_LORA * 2, SZ_WUKV = (size_t)NKV_UP * KV_LORA * 2,
                 SZ_WOUT = (size_t)DM * DM * 2, SZ_WUP = (size_t)DFF * DM * 2, SZ_WDN = (size_t)DM * DFF * 2;
constexpr size_t WS_WIN = WS_W, WS_WUQ = WS_WIN + 2 * SZ_WIN, WS_WUKV = WS_WUQ + 2 * SZ_WUQ, WS_WOUT = WS_WUKV + 2 * SZ_WUKV,
                 WS_WUP = WS_WOUT + 2 * SZ_WOUT, WS_WDN = WS_WUP + 2 * SZ_WUP, WS_WEND = WS_WDN + 2 * SZ_WDN;
constexpr size_t WS_XB = 55 * MiB;
static_assert(WS_WEND <= WS_XB, "weights");
constexpr size_t WS_OV = 87 * MiB;
constexpr size_t WS_U = WS_OV;
constexpr size_t WS_CQ = WS_OV;
constexpr size_t WS_CKV = WS_CQ + 12 * MiB;
constexpr size_t WS_QB = WS_CKV + 8 * MiB;
constexpr size_t WS_QI = WS_QB + 8 * MiB;
constexpr size_t WS_QC = WS_QI + 8 * MiB;
constexpr size_t WS_KI = WS_QC + 8 * MiB;
constexpr size_t WS_WI = WS_KI + 1 * MiB;
constexpr size_t WS_KR = WS_WI + 512 * 1024;
constexpr size_t WS_KB = WS_KR + 1 * MiB;
constexpr size_t WS_VB = WS_KB + 2 * MiB;
constexpr size_t WS_KC = WS_VB + 2 * MiB;
constexpr size_t WS_VC = WS_KC + 8 * MiB;
constexpr size_t WS_QA = WS_VC + 8 * MiB;
constexpr size_t WS_KN = WS_QA + 24 * MiB;
constexpr size_t WS_VA = WS_KN + 16 * MiB;
constexpr size_t WS_BM = WS_VA + 16 * MiB;
constexpr size_t WS_MIX = WS_BM + 8 * MiB;
constexpr size_t WS_END = WS_MIX + 32 * MiB;
constexpr size_t WS_ROPE = 250 * MiB;
static_assert(WS_END <= WS_ROPE && WS_ROPE + (size_t)T * 128 <= 256 * MiB && WS_U + (size_t)T * DFF * 2 <= 256 * MiB, "workspace");

struct P {
    const float *x, *rel_bias, *norm_attn, *w_in, *q_norm, *w_uq, *kv_norm, *w_ukv, *diff_lambda, *diff_subln, *w_out, *norm_mlp, *w_up, *w_down, *norm_final;
    const int* pos;
    float* out;
    unsigned char* ws;
};

__device__ __forceinline__ int phase_tid(int wave) { int t; asm volatile("v_mbcnt_lo_u32_b32 %0, -1, 0\n\tv_mbcnt_hi_u32_b32 %0, -1, %0" : "=v"(t)); return wave * 64 + t; }
__device__ __forceinline__ unsigned f2bf(float f) { unsigned u = __builtin_bit_cast(unsigned, f); return (u + 0x7fffu + ((u >> 16) & 1u)) >> 16; }
__device__ __forceinline__ float bf2f(unsigned b) { return __builtin_bit_cast(float, (b & 0xffffu) << 16); }
__device__ __forceinline__ unsigned pk2(float lo, float hi) { unsigned r; asm("v_cvt_pk_bf16_f32 %0, %1, %2" : "=v"(r) : "v"(lo), "v"(hi)); return r; }
__device__ __forceinline__ u32x4 pk8(const float (&v)[8]) { u32x4 w; w.x = pk2(v[0], v[1]); w.y = pk2(v[2], v[3]); w.z = pk2(v[4], v[5]); w.w = pk2(v[6], v[7]); return w; }
__device__ __forceinline__ void unpk8(u32x4 w, float (&v)[8]) {
    v[0] = bf2f(w.x); v[1] = bf2f(w.x >> 16); v[2] = bf2f(w.y); v[3] = bf2f(w.y >> 16); v[4] = bf2f(w.z); v[5] = bf2f(w.z >> 16); v[6] = bf2f(w.w); v[7] = bf2f(w.w >> 16); }

__device__ __forceinline__ size_t kimg(int g, int s, int d, int nch) { return (((size_t)g * NT64 + (s >> 6)) * nch + (d >> 3)) * 512 + (s & 63) * 8 + (d & 7); }
__device__ __forceinline__ size_t vimg(int g, int s, int d) { return (((size_t)g * NT64 + (s >> 6)) * 2 + (d >> 5)) * 2048 + (s & 63) * 32 + (d & 31); }

__device__ __forceinline__ int t5_bucket(int rel) {
    const int n = rel > 0 ? rel : 0;
    if (n < 16) return n;
    const float nf = (float)n;
    int large = 16 + (int)(logf(nf / 16.f) / 2.0794415416798357f * 16.f);
    return large < 31 ? large : 31;
}
__device__ __forceinline__ float lam_init_of(int l) { return l == 0 ? 0.2f : (float)(0.8 - 0.6 * 0.7408182206817179); }
__device__ __forceinline__ float rope_freq(int i) { return powf(10000.f, -(float)i / 16.f); }

__device__ __forceinline__ float rstd_of(const float* parts, int row, int n, int dim) {
    float s = 0.f; const float* p = parts + (size_t)row * n;
    for (int i = 0; i < n; ++i) s += p[i];
    return 1.0f / sqrtf(s / (float)dim + EPS);
}

__device__ __forceinline__ void rope4(const P& p, int row, int i0, float (&v)[8]) {
    const float* t = (const float*)(p.ws + WS_ROPE) + (size_t)row * 32 + 2 * i0;
    const f32x4 a = *(const GAS f32x4*)t, b = *(const GAS f32x4*)(t + 4);
    const float cs[4] = {a.x, a.z, b.x, b.z}, sn[4] = {a.y, a.w, b.y, b.w};
#pragma unroll
    for (int q = 0; q < 4; ++q) { const float x1 = v[2 * q], x2 = v[2 * q + 1]; v[2 * q] = x1 * cs[q] - x2 * sn[q]; v[2 * q + 1] = x1 * sn[q] + x2 * cs[q]; }
}
__device__ __forceinline__ void prep_rope(const P& p, int idx) {
    const int row = idx >> 4, i = idx & 15; const float ang = (float)p.pos[row] * rope_freq(i); float sn, cs; sincosf(ang, &sn, &cs);
    float* t = (float*)(p.ws + WS_ROPE) + (size_t)idx * 2; t[0] = cs; t[1] = sn;
}
enum { EPI_IN = 0, EPI_QUP = 1, EPI_KVUP = 2, EPI_OUT = 3, EPI_UP = 4, EPI_DOWN = 5, EPI_IN8 = 6 };

template <int EPI> __device__ __forceinline__ float epi_row_scale(const P& p, int layer, int row) {
    const unsigned char* ws = p.ws;
    if (EPI == EPI_IN || EPI == EPI_IN8) return rstd_of((const float*)(ws + WS_RSA), row, 32, DM);
    if (EPI == EPI_QUP) return rstd_of((const float*)(ws + WS_RSCQ), row, 12, Q_LORA) * (0.10206207261596575f * LOG2E);
    if (EPI == EPI_KVUP) return rstd_of((const float*)(ws + WS_RSCKV), row, 8, KV_LORA);
    if (EPI == EPI_UP) return rstd_of((const float*)(ws + WS_RSB), row, 32, DM);
    return 1.f;
}

template <int EPI> __device__ __forceinline__ float epi8(const P& p, int layer, int row, int c0, float (&v)[8], float rs, int cs = -1) {
    if (cs < 0) cs = c0;
    unsigned char* ws = p.ws;
    const int b = row >> 12, s = row & (S - 1);
    float ss = 0.f;
    if (EPI == EPI_IN) {
#pragma unroll
        for (int j = 0; j < 8; ++j) v[j] *= rs;
        if (cs < 384) {
            u32x4 w = pk8(v); float r[8]; unpk8(w, r);
#pragma unroll
            for (int j = 0; j < 8; ++j) ss += r[j] * r[j];
            *(GAS u32x4*)((bf16_t*)(ws + WS_CQ) + (size_t)row * Q_LORA + c0) = w;
        } else if (cs < 416) {
            const int j0 = c0 - 384; rope4(p, row, j0 >> 1, v);
            *(GAS u32x4*)((bf16_t*)(ws + WS_KR) + kimg(b, s, j0, 4)) = pk8(v);
        } else if (cs < 448) {
            *(GAS u32x4*)((bf16_t*)(ws + WS_KI) + (size_t)row * 32 + (c0 - 416)) = pk8(v);
        } else if (cs < 480 && c0 < 456) {
            float* o = (float*)(ws + WS_WI) + (size_t)row * 8;
            *(GAS f32x4*)o = (f32x4){v[0], v[1], v[2], v[3]}; *(GAS f32x4*)(o + 4) = (f32x4){v[4], v[5], v[6], v[7]};
        } else if (cs < 512) {
        } else if (cs < 768) {
            u32x4 w = pk8(v); float r[8]; unpk8(w, r);
#pragma unroll
            for (int j = 0; j < 8; ++j) ss += r[j] * r[j];
            *(GAS u32x4*)((bf16_t*)(ws + WS_CKV) + (size_t)row * KV_LORA + (c0 - 512)) = w;
        } else if (cs < 1024) {
#pragma unroll
            for (int j = 0; j < 8; ++j) v[j] *= 0.125f * LOG2E;
            *(GAS u32x4*)((bf16_t*)(ws + WS_QB) + (size_t)row * 256 + (c0 - 768)) = pk8(v);
        } else if (cs < 1280) {
            *(GAS u32x4*)((bf16_t*)(ws + WS_QI) + (size_t)row * 256 + (c0 - 1024)) = pk8(v);
        } else if (cs < 1536) {
#pragma unroll
            for (int j = 0; j < 8; ++j) v[j] *= 0.17677669529663687f * LOG2E;
            *(GAS u32x4*)((bf16_t*)(ws + WS_QC) + (size_t)row * 256 + (c0 - 1280)) = pk8(v);
        } else if (cs < 1792) {
            const int j0 = c0 - 1536, h = j0 >> 6, cd = j0 & 63;
            *(GAS u32x4*)((bf16_t*)(ws + WS_KC) + kimg(b * 4 + h, s, cd, 8)) = pk8(v);
        } else if (cs < 2048) {
            const int j0 = c0 - 1792, h = j0 >> 6, d = j0 & 63;
            *(GAS u32x4*)((bf16_t*)(ws + WS_VC) + vimg(b * 4 + h, s, d)) = pk8(v);
        }
    } else if (EPI == EPI_IN8) {
#pragma unroll
        for (int j = 0; j < 8; ++j) v[j] *= rs;
        if (c0 < 2112) {
            *(GAS u32x4*)((bf16_t*)(ws + WS_KB) + kimg(b, s, c0 - 2048, 8)) = pk8(v);
        } else if (c0 < 2176) {
            *(GAS u32x4*)((bf16_t*)(ws + WS_VB) + vimg(b, s, c0 - 2112)) = pk8(v);
        }
    } else if (EPI == EPI_QUP) {
#pragma unroll
        for (int j = 0; j < 8; ++j) v[j] *= rs;
        const int j0 = c0 % 96;
        if (j0 >= 64) rope4(p, row, (j0 - 64) >> 1, v);
        *(GAS u32x4*)((bf16_t*)(ws + WS_QA) + (size_t)row * NQ_UP + c0) = pk8(v);
    } else if (EPI == EPI_KVUP) {
#pragma unroll
        for (int j = 0; j < 8; ++j) v[j] *= rs;
        const int h = c0 >> 7, j0 = c0 & 127;
        if (j0 < 64) *(GAS u32x4*)((bf16_t*)(ws + WS_KN) + kimg(b * 8 + h, s, j0, 8)) = pk8(v);
        else *(GAS u32x4*)((bf16_t*)(ws + WS_VA) + vimg(b * 8 + h, s, j0 - 64)) = pk8(v);
    } else if (EPI == EPI_OUT || EPI == EPI_DOWN) {
        bf16_t* xb = (bf16_t*)(ws + WS_XB) + (size_t)row * DM + c0;
        { float r[8]; unpk8(*(const GAS u32x4*)xb, r);
#pragma unroll
            for (int j = 0; j < 8; ++j) v[j] += r[j]; }
#pragma unroll
        for (int j = 0; j < 8; ++j) ss += v[j] * v[j];
        *(GAS u32x4*)xb = pk8(v);
    } else if (EPI == EPI_UP) {
#pragma unroll
        for (int j = 0; j < 8; ++j) { const float t = fmaxf(v[j] * rs, 0.f); v[j] = t * t; }
        *(GAS u32x4*)((bf16_t*)(ws + WS_U) + (size_t)row * DFF + c0) = pk8(v);
    }
    return ss;
}
template <int EPI> __device__ __forceinline__ void epi_part(const P& p, int row, int c32, float ss) {
    unsigned char* ws = p.ws;
    if (EPI == EPI_IN) {
        if (c32 < 12) ((GAS float*)(ws + WS_RSCQ))[(size_t)row * 12 + c32] = ss;
        else if (c32 >= 16 && c32 < 24) ((GAS float*)(ws + WS_RSCKV))[(size_t)row * 8 + (c32 - 16)] = ss;
    } else if (EPI == EPI_OUT) ((GAS float*)(ws + WS_RSB))[(size_t)row * 32 + c32] = ss;
    else if (EPI == EPI_DOWN) ((GAS float*)(ws + WS_RSA))[(size_t)row * 32 + c32] = ss;
}

enum { WM_IN = 0, WM_UQ = 1, WM_ID = 2 };
__device__ __forceinline__ int colmap(int mode, int np) {
    if (mode == WM_IN) {
        if (np < 384) return np;
        if (np < 416) { const int j = np - 384; return 640 + (j >> 1) + 16 * (j & 1); }
        if (np < 448) return 1312 + (np - 416);
        if (np < 456) return 1344 + (np - 448);
        if (np < 512) return -1;
        if (np < 768) return 384 + (np - 512);
        if (np < 1024) return 672 + (np - 768);
        if (np < 1280) return 1056 + (np - 1024);
        if (np < 1536) return 1352 + (np - 1280);
        if (np < 1792) return 1608 + (np - 1536);
        if (np < 2048) return 1864 + (np - 1792);
        if (np < 2112) return 928 + (np - 2048);
        if (np < 2176) return 992 + (np - 2112);
        return -1;
    }
    if (mode == WM_UQ) { const int h = np / 96, j = np % 96; if (j < 64) return np; const int jj = j - 64; return h * 96 + 64 + (jj >> 1) + 16 * (jj & 1); }
    return np;
}
struct WPrep { const float* w; const float* gain; bf16_t* out; int K, N, NP, mode; };
__device__ __forceinline__ void prep_w_load(const WPrep& a, int tile, int tid, float (&val)[8]) {
    const int ntn = a.NP / 64, kb = tile / ntn, nb = tile % ntn, k0 = kb * 64, n0 = nb * 64;
    const int tx = tid & 63, ty = tid >> 6;
    const int o = colmap(a.mode, n0 + tx);
#pragma unroll
    for (int i = 0; i < 8; ++i) { const int k = k0 + ty + 8 * i; val[i] = 0.f; if (o >= 0) { val[i] = a.w[(size_t)k * a.N + o]; if (a.gain) val[i] *= a.gain[k]; } }
}
__device__ __forceinline__ void prep_w_store(const WPrep& a, int tile, float* lds, int tid, const float (&val)[8]) {
    const int ntn = a.NP / 64, kb = tile / ntn, nb = tile % ntn, k0 = kb * 64, n0 = nb * 64;
    const int tx = tid & 63, ty = tid >> 6;
#pragma unroll
    for (int i = 0; i < 8; ++i) lds[(ty + 8 * i) * 65 + tx] = val[i];
    __syncthreads();
    { const int n = tid >> 3, kc = tid & 7; float v[8];
#pragma unroll
      for (int j = 0; j < 8; ++j) v[j] = lds[(8 * kc + j) * 65 + n];
      *(GAS u32x4*)(a.out + (size_t)(n0 + n) * a.K + k0 + 8 * kc) = pk8(v); }
    __syncthreads();
}
__device__ __forceinline__ WPrep wprep_of(const P& p, int idx) {
    const int l = idx / 6, w = idx % 6; unsigned char* ws = p.ws; WPrep a;
    switch (w) {
    case 0: a = WPrep{p.w_in + (size_t)l * DM * N_IN, p.norm_attn + l * DM, (bf16_t*)(ws + WS_WIN + l * SZ_WIN), DM, N_IN, N_INP, WM_IN}; break;
    case 1: a = WPrep{p.w_uq + (size_t)l * Q_LORA * NQ_UP, p.q_norm + l * Q_LORA, (bf16_t*)(ws + WS_WUQ + l * SZ_WUQ), Q_LORA, NQ_UP, NQ_UP, WM_UQ}; break;
    case 2: a = WPrep{p.w_ukv + (size_t)l * KV_LORA * NKV_UP, p.kv_norm + l * KV_LORA, (bf16_t*)(ws + WS_WUKV + l * SZ_WUKV), KV_LORA, NKV_UP, NKV_UP, WM_ID}; break;
    case 3: a = WPrep{p.w_out + (size_t)l * DM * DM, nullptr, (bf16_t*)(ws + WS_WOUT + l * SZ_WOUT), DM, DM, DM, WM_ID}; break;
    case 4: a = WPrep{p.w_up + (size_t)l * DM * DFF, p.norm_mlp + l * DM, (bf16_t*)(ws + WS_WUP + l * SZ_WUP), DM, DFF, DFF, WM_ID}; break;
    default: a = WPrep{p.w_down + (size_t)l * DFF * DM, nullptr, (bf16_t*)(ws + WS_WDN + l * SZ_WDN), DFF, DM, DM, WM_ID}; break;
    }
    return a;
}
__device__ __forceinline__ int wprep_tiles(int idx) {
    switch (idx % 6) { case 0: return (DM / 64) * (N_INP / 64); case 1: return (Q_LORA / 64) * (NQ_UP / 64); case 2: return (KV_LORA / 64) * (NKV_UP / 64);
                       case 3: return (DM / 64) * (DM / 64); case 4: return (DM / 64) * (DFF / 64); default: return (DFF / 64) * (DM / 64); }
}
__device__ __forceinline__ void prep_w_range(const P& p, int m0, int m1, int me, int nw, float* scr, int tid) {
    int total = 0;
    for (int i = m0; i < m1; ++i) total += wprep_tiles(i);
    int g = me, mi = m0, base = 0;
    while (mi < m1 && g >= base + wprep_tiles(mi)) { base += wprep_tiles(mi); ++mi; }
    float cur[8], nxt[8];
    if (g < total) { const WPrep w = wprep_of(p, mi); prep_w_load(w, g - base, tid, cur); }
    while (g < total) {
        const int g2 = g + nw; int mi2 = mi, base2 = base;
        while (mi2 < m1 && g2 >= base2 + wprep_tiles(mi2)) { base2 += wprep_tiles(mi2); ++mi2; }
        if (g2 < total) { const WPrep w2 = wprep_of(p, mi2); prep_w_load(w2, g2 - base2, tid, nxt); }
        { const WPrep w = wprep_of(p, mi); prep_w_store(w, g - base, scr, tid, cur); }
#pragma unroll
        for (int i = 0; i < 8; ++i) cur[i] = nxt[i];
        g = g2; mi = mi2; base = base2;
    }
}
__device__ __forceinline__ void prep_x_row(const P& p, int row, int lane) {
    const float* xr = p.x + (size_t)row * DM + lane * 16;
    float v[16];
#pragma unroll
    for (int j = 0; j < 4; ++j) { const f32x4 a = *(const GAS f32x4*)(xr + 4 * j); v[4 * j] = a.x; v[4 * j + 1] = a.y; v[4 * j + 2] = a.z; v[4 * j + 3] = a.w; }
    float ss = 0.f;
#pragma unroll
    for (int j = 0; j < 16; ++j) ss += v[j] * v[j];
    ss += __shfl_xor(ss, 1);
    if ((lane & 1) == 0) ((float*)(p.ws + WS_RSA))[(size_t)row * 32 + (lane >> 1)] = ss;
    bf16_t* xb = (bf16_t*)(p.ws + WS_XB) + (size_t)row * DM + lane * 16;
    float a8[8], b8[8];
#pragma unroll
    for (int j = 0; j < 8; ++j) { a8[j] = v[j]; b8[j] = v[8 + j]; }
    *(GAS u32x4*)xb = pk8(a8); *(GAS u32x4*)(xb + 8) = pk8(b8);
}
__device__ __forceinline__ void prep_lut(const P& p, int i) {
    if (i < 129 * 8) { const int rel = i >> 3, h = i & 7; ((float*)(p.ws + WS_MISC))[i] = p.rel_bias[t5_bucket(rel) * 8 + h] * LOG2E; }
}
namespace pg8 {
#define PG8_LAS __attribute__((address_space(3)))
constexpr int BM = 256, BK = 64, HALF = 128, HTB = HALF * BK * 2  , STAGE_BYTES = 8 * HTB, NXCD = 8, WGM = 8;

__host__ __device__ __forceinline__ int lds_byte(int r, int c) { const int st = (r >> 4) * 2 + (c >> 5), rr = r & 15, cc = c & 31, ob = rr * 64 + cc * 2; return st * 1024 + (ob ^ (((ob >> 9) & 1) << 5)); }
__host__ __device__ __forceinline__ void stage_rc(int b, int& R, int& C) { const int st = b / 1024, sb = b % 1024, swz = sb ^ (((sb >> 9) & 1) << 5); R = (st >> 1) * 16 + swz / 64; C = (st & 1) * 32 + (swz % 64) / 2; }
__host__ __device__ __forceinline__ int perm32(int rho) { const int n = rho >> 4, i = rho & 15; return 8 * (i >> 2) + 4 * n + (i & 3); }

struct Unit { int pm, pn; };
struct Gemm { const bf16_t* A; const bf16_t* Bt; int M, N, K; };

struct StaticOrder {
    int nM, nN, nwg, G, c;
    __host__ __device__ void init(int M, int N, int G_, int c_) { nM = M / BM; nN = N / BM; nwg = nM * nN; G = G_; c = c_; }
    __host__ __device__ bool next(int i, Unit& u) const {
        const long L = (long)i * G + c; if (L >= nwg) return false;
        int wgid = (int)L; { const int q = nwg / NXCD, r = nwg % NXCD, xcd = wgid % NXCD, off = wgid / NXCD; wgid = (xcd < r ? xcd * (q + 1) : r * (q + 1) + (xcd - r) * q) + off; }
        const int nig = WGM * nN, gid = wgid / nig, fm = gid * WGM, gsz = (nM - fm) < WGM ? (nM - fm) : WGM;
        u.pm = fm + ((wgid % nig) % gsz); u.pn = (wgid % nig) / gsz; return true;
    }
    __device__ __forceinline__ void a_ready(const Unit&) const {}
    __device__ __forceinline__ void done(const Unit&) const {}
};
template <class Epi, class Sched, bool ALIGN_EPI = false, bool SP2 = false>
__device__ __forceinline__ void gemm_phase(PG8_LAS unsigned char* lds, const Gemm g, const Sched& S, const Epi& E, int wave_id) {
    const int tid_ = phase_tid(wave_id);
    const int tid = tid_, wid = __builtin_amdgcn_readfirstlane(tid >> 6), lane = tid & 63, wr = wid >> 2, wc = wid & 3, fr = lane & 15, fq = lane >> 4;
    const int K = g.K, nt = K / BK;
    unsigned voffA[2], voffB[2];
#pragma unroll
    for (int i = 0; i < 2; ++i) { int R, C; stage_rc(tid * 16 + i * 8192, R, C); const int Rb = Epi::PERM ? ((R & ~31) + perm32(R & 31)) : R;
        voffA[i] = (unsigned)(R * K + C) * 2u; voffB[i] = (unsigned)(Rb * K + C) * 2u; }
    const size_t kstep = (size_t)(BK * 2);
    const size_t hstep = (size_t)HALF * K * 2;
    const size_t tstep = 2 * hstep;
    const unsigned ldsw = (unsigned)wid * 1024u;
    const int aoff = lds_byte(wr * 64 + fr, fq * 8), boff = lds_byte(wc * 32 + fr, fq * 8);
#define PG8_SA(b, h) (((b) * 2 + (h)) * HTB)
#define PG8_SB(b, h) ((4 + (b) * 2 + (h)) * HTB)
#define PG8_STAGE(bufoff, gbase, voff) do { _Pragma("unroll") for (int _i = 0; _i < 2; ++_i) \
        __builtin_amdgcn_global_load_lds((const unsigned*)((const char*)(gbase) + (voff)[_i]), (PG8_LAS unsigned*)(lds + (bufoff) + ldsw + _i * 8192), 16, 0, 0); } while (0)
#define PG8_LDA(dst, b, h) do { _Pragma("unroll") for (int m = 0; m < 4; ++m) _Pragma("unroll") for (int k = 0; k < 2; ++k) dst[m][k] = *(const PG8_LAS bf16x8*)(lds + PG8_SA(b, h) + aoff + m * 2048 + k * 1024); } while (0)
#define PG8_LDB(dst, b, h) do { _Pragma("unroll") for (int n = 0; n < 2; ++n) _Pragma("unroll") for (int k = 0; k < 2; ++k) dst[n][k] = *(const PG8_LAS bf16x8*)(lds + PG8_SB(b, h) + boff + n * 2048 + k * 1024); } while (0)
#define PG8_MMA(ai, bj, At, Bt) do { __builtin_amdgcn_s_setprio(1); _Pragma("unroll") for (int m = 0; m < 4; ++m) _Pragma("unroll") for (int n = 0; n < 2; ++n) _Pragma("unroll") for (int k = 0; k < 2; ++k) \
        acc[ai][bj][m][n] = __builtin_amdgcn_mfma_f32_16x16x32_bf16(Bt[n][k], At[m][k], acc[ai][bj][m][n], 0, 0, 0); __builtin_amdgcn_s_setprio(0); } while (0)
#define PG8_WAIT_V(n) asm volatile("s_waitcnt vmcnt(" #n ")" ::: "memory")
#define PG8_WAIT_L(n) asm volatile("s_waitcnt lgkmcnt(" #n ")" ::: "memory")
#define PG8_BAR __builtin_amdgcn_s_barrier()
#define PG8_SCHED __builtin_amdgcn_sched_barrier(0)
    Unit cur, nxt; int ui = 0;
    if (!S.next(0, cur)) return;
    f32x4 acc[2][2][4][2];
#pragma unroll
    for (int a = 0; a < 2; ++a)
#pragma unroll
        for (int b = 0; b < 2; ++b)
#pragma unroll
            for (int m = 0; m < 4; ++m)
#pragma unroll
                for (int n = 0; n < 2; ++n) acc[a][b][m][n] = (f32x4){0.f, 0.f, 0.f, 0.f};
    bf16x8 At[4][2], B0[2][2], B1[2][2];
    const char* cA = (const char*)g.A + (size_t)cur.pm * tstep; const char* cB = (const char*)g.Bt + (size_t)cur.pn * tstep;
    S.a_ready(cur);
    if constexpr (SP2) {
        PG8_STAGE(PG8_SB(0, 0), cB, voffB); PG8_STAGE(PG8_SB(0, 1), cB + hstep, voffB); PG8_STAGE(PG8_SA(0, 0), cA, voffA); PG8_STAGE(PG8_SA(0, 1), cA + hstep, voffA);
        if (wr == 1) PG8_BAR;
        PG8_WAIT_V(2); PG8_BAR;
        PG8_STAGE(PG8_SB(1, 0), cB + kstep, voffB); PG8_STAGE(PG8_SA(1, 0), cA + kstep, voffA); PG8_STAGE(PG8_SB(1, 1), cB + hstep + kstep, voffB);
        PG8_WAIT_V(6); PG8_BAR;
    } else {
        PG8_STAGE(PG8_SB(0, 0), cB, voffB); PG8_STAGE(PG8_SA(0, 0), cA, voffA); PG8_STAGE(PG8_SB(0, 1), cB + hstep, voffB); PG8_STAGE(PG8_SA(0, 1), cA + hstep, voffA);
        if (wr == 1) PG8_BAR;
        PG8_WAIT_V(4); PG8_BAR;
        PG8_STAGE(PG8_SB(1, 0), cB + kstep, voffB); PG8_STAGE(PG8_SA(1, 0), cA + kstep, voffA); PG8_STAGE(PG8_SB(1, 1), cB + hstep + kstep, voffB);
        PG8_WAIT_V(6); PG8_BAR;
    }
    for (;;) {
        const bool has_next = S.next(ui + 1, nxt);
        const char* nA = has_next ? (const char*)g.A + (size_t)nxt.pm * tstep : cA; const char* nB = has_next ? (const char*)g.Bt + (size_t)nxt.pn * tstep : cB;
#pragma unroll 1
        for (int t = 0; t < nt; t += 2) {
            const bool last = (t == nt - 2);
            const char* a1 = cA + (size_t)(t + 1) * kstep;
            const char* a2 = last ? nA : cA + (size_t)(t + 2) * kstep; const char* b2 = last ? nB : cB + (size_t)(t + 2) * kstep;
            const char* a3 = a2 + kstep; const char* b3 = b2 + kstep;
            if (last && has_next) S.a_ready(nxt);
            if constexpr (SP2) {
            PG8_LDB(B0, 0, 0); PG8_LDB(B1, 0, 1); PG8_SCHED; PG8_LDA(At, 0, 0); PG8_STAGE(PG8_SA(1, 1), a1 + hstep, voffA);
            PG8_WAIT_V(8); PG8_WAIT_L(0); PG8_BAR; PG8_MMA(0, 0, At, B0); PG8_MMA(0, 1, At, B1); PG8_BAR; PG8_SCHED;
            PG8_LDA(At, 0, 1); PG8_STAGE(PG8_SB(0, 0), b2, voffB); PG8_STAGE(PG8_SB(0, 1), b2 + hstep, voffB); PG8_STAGE(PG8_SA(0, 0), a2, voffA);
            PG8_WAIT_V(8); PG8_WAIT_L(0); PG8_BAR; PG8_MMA(1, 0, At, B0); PG8_MMA(1, 1, At, B1); PG8_BAR; PG8_SCHED;
            PG8_LDB(B0, 1, 0); PG8_LDB(B1, 1, 1); PG8_SCHED; PG8_LDA(At, 1, 0); PG8_STAGE(PG8_SA(0, 1), a2 + hstep, voffA);
            PG8_WAIT_V(8); PG8_WAIT_L(0); PG8_BAR; PG8_MMA(0, 0, At, B0); PG8_MMA(0, 1, At, B1); PG8_BAR; PG8_SCHED;
            PG8_LDA(At, 1, 1); PG8_STAGE(PG8_SB(1, 0), b3, voffB); PG8_STAGE(PG8_SB(1, 1), b3 + hstep, voffB); PG8_STAGE(PG8_SA(1, 0), a3, voffA);
            PG8_WAIT_V(8); PG8_WAIT_L(0); PG8_BAR; PG8_MMA(1, 0, At, B0); PG8_MMA(1, 1, At, B1); PG8_BAR; PG8_SCHED;
            } else {
            PG8_LDB(B0, 0, 0); PG8_SCHED; PG8_LDA(At, 0, 0); PG8_STAGE(PG8_SA(1, 1), a1 + hstep, voffA);
            PG8_WAIT_L(8); PG8_BAR; PG8_WAIT_L(0); PG8_MMA(0, 0, At, B0); PG8_BAR; PG8_SCHED;
            PG8_LDB(B1, 0, 1); PG8_STAGE(PG8_SB(0, 0), b2, voffB);
            PG8_BAR; PG8_WAIT_L(0); PG8_MMA(0, 1, At, B1); PG8_BAR;
            PG8_LDA(At, 0, 1); PG8_STAGE(PG8_SA(0, 0), a2, voffA);
            PG8_BAR; PG8_WAIT_L(0); PG8_MMA(1, 0, At, B0); PG8_BAR; PG8_SCHED;
            PG8_STAGE(PG8_SB(0, 1), b2 + hstep, voffB);
            PG8_WAIT_V(6); PG8_BAR; PG8_MMA(1, 1, At, B1); PG8_BAR;
            PG8_LDB(B0, 1, 0); PG8_SCHED; PG8_LDA(At, 1, 0); PG8_STAGE(PG8_SA(0, 1), a2 + hstep, voffA);
            PG8_WAIT_L(8); PG8_BAR; PG8_WAIT_L(0); PG8_MMA(0, 0, At, B0); PG8_BAR; PG8_SCHED;
            PG8_LDB(B1, 1, 1); PG8_STAGE(PG8_SB(1, 0), b3, voffB);
            PG8_BAR; PG8_WAIT_L(0); PG8_MMA(0, 1, At, B1); PG8_BAR;
            PG8_LDA(At, 1, 1); PG8_STAGE(PG8_SA(1, 0), a3, voffA);
            PG8_BAR; PG8_WAIT_L(0); PG8_MMA(1, 0, At, B0); PG8_BAR; PG8_SCHED;
            PG8_STAGE(PG8_SB(1, 1), b3 + hstep, voffB);
            PG8_WAIT_V(6); PG8_BAR; PG8_MMA(1, 1, At, B1); PG8_BAR;
            }
        }
        if constexpr (ALIGN_EPI) { if (wr == 0) PG8_BAR; }
        if constexpr (!Epi::AFTER_DRAIN) { E(acc, cur, wr, wc, fr, fq); S.done(cur); }
        if (!has_next) break;
#pragma unroll
        for (int a = 0; a < 2; ++a)
#pragma unroll
            for (int b = 0; b < 2; ++b)
#pragma unroll
                for (int m = 0; m < 4; ++m)
#pragma unroll
                    for (int n = 0; n < 2; ++n) acc[a][b][m][n] = (f32x4){0.f, 0.f, 0.f, 0.f};
        cur = nxt; cA = nA; cB = nB; ++ui;
        if constexpr (ALIGN_EPI) { if (wr == 1) PG8_BAR; }
    }
    PG8_WAIT_V(0);
    if constexpr (!ALIGN_EPI) { if (wr == 0) PG8_BAR; }
    PG8_BAR;
    if constexpr (Epi::AFTER_DRAIN) { E.fused(acc, cur, wr, wc, fr, fq, lds, wid, lane); S.done(cur); }
#undef PG8_SA
#undef PG8_SB
#undef PG8_STAGE
#undef PG8_LDA
#undef PG8_LDB
#undef PG8_MMA
#undef PG8_WAIT_V
#undef PG8_WAIT_L
#undef PG8_BAR
#undef PG8_SCHED
}
}
#define LAS __attribute__((address_space(3)))
#define XB_TMO      128
#define XB_XCNT(j)  (256  + 64 * (j))
#define XB_XSUB(j)  (1280 + 64 * (j))
#define XB_XGEN(j)  (2304 + 64 * (j))
#define XB_TOP      3328
#define XB_TOPGEN   3392
#define XCD_BAR_WORDS 3456
#define XB_SPIN_CAP (1u << 18)

__device__ __forceinline__ unsigned xb_ld(unsigned* p)              { return __hip_atomic_load(p, __ATOMIC_RELAXED, __HIP_MEMORY_SCOPE_AGENT); }
__device__ __forceinline__ unsigned xb_add(unsigned* p, unsigned v) { return __hip_atomic_fetch_add(p, v, __ATOMIC_RELAXED, __HIP_MEMORY_SCOPE_AGENT); }
__device__ __forceinline__ unsigned xb_xcc_id() { return (unsigned)__builtin_amdgcn_s_getreg((3 << 11) | 20) & 0xFu; }
#define XB_SPIN(cond, bar) do { unsigned _sp = 0; while (cond) { __builtin_amdgcn_s_sleep(1); \
    if ((++_sp & 255u) == 0u) { if (xb_ld(&(bar)[XB_TMO])) break; if (_sp > XB_SPIN_CAP) { atomicAdd(&(bar)[XB_TMO], 1u); break; } } } } while (0)

struct XcdBarrier {
    unsigned* bar; unsigned x;
    volatile LAS unsigned* st;
};

__device__ __forceinline__ XcdBarrier xcd_barrier_post(unsigned* bar, volatile LAS unsigned* st, int tid) {
    XcdBarrier b; b.bar = bar; b.x = xb_xcc_id(); b.st = st;
    if (tid == 0) (void)xb_add(&bar[XB_XCNT(b.x)], 1u);
    return b;
}
__device__ __forceinline__ void xcd_barrier_complete(unsigned* bar, unsigned x, unsigned& nloc, unsigned& nx) {
    const unsigned G = gridDim.x * gridDim.y * gridDim.z;
    unsigned sum, cnt, mine, sp = 0u;
    for (;;) {
        sum = 0u; cnt = 0u; mine = 0u;
#pragma unroll
        for (unsigned j = 0; j < 16; ++j) { const unsigned c = xb_ld(&bar[XB_XCNT(j)]); sum += c; cnt += (c > 0u) ? 1u : 0u; mine = (j == x) ? c : mine; }
        if (sum == G) break;
        __builtin_amdgcn_s_sleep(1);
        if ((++sp & 255u) == 0u) { if (xb_ld(&bar[XB_TMO])) break; if (sp > XB_SPIN_CAP) { atomicAdd(&bar[XB_TMO], 1u); break; } }
    }
    nloc = mine > 0u ? mine : 1u; nx = cnt > 0u ? cnt : 1u;
}

__device__ __forceinline__ void xcd_barrier(const XcdBarrier& b, int tid) {
    asm volatile("s_waitcnt vmcnt(0)" ::: "memory");
    __syncthreads();
    if (tid == 0) {
        unsigned* bar = b.bar; unsigned bx = b.x;
        asm volatile("" : "+s"(bar), "+s"(bx));
        __builtin_amdgcn_s_waitcnt(0);
        unsigned nloc = b.st[0], nx = b.st[1];
        if (nloc == 0u) { xcd_barrier_complete(bar, bx, nloc, nx); b.st[0] = nloc; b.st[1] = nx; }
        const unsigned old = xb_add(&bar[XB_XSUB(bx)], 1u);
        const unsigned gen = old / nloc;
        if (old + 1u == (gen + 1u) * nloc) {
            __builtin_amdgcn_fence(__ATOMIC_RELEASE, "agent");
            asm volatile("s_waitcnt vmcnt(0)" ::: "memory");
            const unsigned og = xb_add(&bar[XB_TOP], 1u);
            const unsigned tg = og / nx;
            if (og + 1u == (tg + 1u) * nx) xb_add(&bar[XB_TOPGEN], 1u);
            else XB_SPIN(xb_ld(&bar[XB_TOPGEN]) == tg, bar);
            __builtin_amdgcn_fence(__ATOMIC_ACQUIRE, "agent");
            xb_add(&bar[XB_XGEN(bx)], 1u);
            asm volatile("s_waitcnt vmcnt(0)" ::: "memory");
        } else {
            XB_SPIN(xb_ld(&bar[XB_XGEN(bx)]) == gen, bar);
            __builtin_amdgcn_fence(__ATOMIC_ACQUIRE, "agent");
            asm volatile("s_waitcnt vmcnt(0)" ::: "memory");
        }
    }
    __syncthreads();
}
constexpr int NWAVES = 8;
constexpr int RING_BYTES = 131072;
constexpr int LDSCTL_OFF = RING_BYTES + 8192 + 512, MISC_OFF = LDSCTL_OFF;
constexpr int LDS_BYTES = 147456;
constexpr size_t CTL_ZERO_BYTES = 1 * MiB;
constexpr int CW_BAR = 4096;
constexpr int CW_AFF = 12288;
constexpr int CW_WQ = 16384;
constexpr int CW_FIN = 20480;
constexpr size_t MISC_FINX = 65536;

template <int EPI> __device__ __forceinline__ float fast_row_scale(const P& p, int row, int fq) {
    const unsigned char* ws = p.ws; float s = 0.f;
    if (EPI == EPI_IN || EPI == EPI_IN8 || EPI == EPI_UP) { const float* q = (const float*)(ws + (EPI == EPI_UP ? WS_RSB : WS_RSA)) + (size_t)row * 32 + 8 * fq;
        const f32x4 a = *(const GAS f32x4*)q, b = *(const GAS f32x4*)(q + 4); s = ((a.x + a.y) + (a.z + a.w)) + ((b.x + b.y) + (b.z + b.w)); }
    else if (EPI == EPI_QUP) { if (fq < 3) { const f32x4 a = *(const GAS f32x4*)((const float*)(ws + WS_RSCQ) + (size_t)row * 12 + 4 * fq); s = (a.x + a.y) + (a.z + a.w); } }
    else if (EPI == EPI_KVUP) { const GAS float* q = (const GAS float*)(ws + WS_RSCKV) + (size_t)row * 8 + 2 * fq; s = q[0] + q[1]; }
    else return 1.f;
    s += __shfl_xor(s, 16); s += __shfl_xor(s, 32);
    if (EPI == EPI_IN || EPI == EPI_IN8 || EPI == EPI_UP) return 1.0f / sqrtf(s / (float)DM + EPS);
    if (EPI == EPI_QUP) return 1.0f / sqrtf(s / (float)Q_LORA + EPS) * (0.10206207261596575f * LOG2E);
    return 1.0f / sqrtf(s / (float)KV_LORA + EPS);
}
constexpr int RT_OFF = RING_BYTES;
template <int EPI> __device__ __forceinline__ void row_scale_table(const P& p, int pm, PG8_LAS unsigned char* lds, int wave) {
    const int tid = phase_tid(wave);
    if (tid < 256) { const int row = pm * 256 + tid; const unsigned char* ws = p.ws; float s = 0.f, r;
        if (EPI == EPI_IN || EPI == EPI_IN8 || EPI == EPI_UP) { const GAS f32x4* q = (const GAS f32x4*)((const float*)(ws + (EPI == EPI_UP ? WS_RSB : WS_RSA)) + (size_t)row * 32);
#pragma unroll
            for (int i = 0; i < 8; ++i) { const f32x4 a = q[i]; s += (a.x + a.y) + (a.z + a.w); }
            r = 1.0f / sqrtf(s / (float)DM + EPS); }
        else if (EPI == EPI_QUP) { const GAS f32x4* q = (const GAS f32x4*)((const float*)(ws + WS_RSCQ) + (size_t)row * 12);
#pragma unroll
            for (int i = 0; i < 3; ++i) { const f32x4 a = q[i]; s += (a.x + a.y) + (a.z + a.w); }
            r = 1.0f / sqrtf(s / (float)Q_LORA + EPS) * (0.10206207261596575f * LOG2E); }
        else { const GAS f32x4* q = (const GAS f32x4*)((const float*)(ws + WS_RSCKV) + (size_t)row * 8);
#pragma unroll
            for (int i = 0; i < 2; ++i) { const f32x4 a = q[i]; s += (a.x + a.y) + (a.z + a.w); }
            r = 1.0f / sqrtf(s / (float)KV_LORA + EPS); }
        ((PG8_LAS float*)(lds + RT_OFF))[tid] = r; }
    __syncthreads();
}
template <int EPI> struct EpiX {
    static constexpr bool PERM = true, AFTER_DRAIN = false;
    static constexpr bool SCALED = (EPI == EPI_IN || EPI == EPI_IN8 || EPI == EPI_UP || EPI == EPI_QUP || EPI == EPI_KVUP);
    P p; int layer; int col_off; PG8_LAS const float* rt;
    __device__ __forceinline__ void operator()(const f32x4 (&acc)[2][2][4][2], const pg8::Unit& u, int wr, int wc, int fr, int fq) const {
        P p = this->p; asm volatile("" : "+s"(p.ws));
        int upm = u.pm, upn = u.pn; asm volatile("" : "+s"(upm), "+s"(upn));
#pragma unroll
        for (int ai = 0; ai < 2; ++ai)
#pragma unroll
            for (int m = 0; m < 4; ++m) {
                const int row = upm * 256 + ai * 128 + wr * 64 + m * 16 + fr;
                const float rs = (SCALED && rt) ? rt[ai * 128 + wr * 64 + m * 16 + fr] : fast_row_scale<EPI>(p, row, fq);
#pragma unroll
                for (int bj = 0; bj < 2; ++bj) {
                    const int c0 = col_off + upn * 256 + bj * 128 + wc * 32 + 8 * fq;
                    float v[8] = {acc[ai][bj][m][0][0], acc[ai][bj][m][0][1], acc[ai][bj][m][0][2], acc[ai][bj][m][0][3], acc[ai][bj][m][1][0], acc[ai][bj][m][1][1], acc[ai][bj][m][1][2], acc[ai][bj][m][1][3]};
                    const int cs = __builtin_amdgcn_readfirstlane(c0 - 8 * fq);
                    float ss = epi8<EPI>(p, layer, row, c0, v, rs, cs);
                    if (EPI == EPI_IN || EPI == EPI_OUT || EPI == EPI_DOWN) {
                        ss += __shfl_xor(ss, 16); ss += __shfl_xor(ss, 32);
                        if (fq == 0) epi_part<EPI>(p, row, c0 >> 5, ss);
                    }
                }
            }
    }
};
struct EpiNone {
    static constexpr bool PERM = true, AFTER_DRAIN = false;
    P p;
    __device__ __forceinline__ void operator()(const f32x4 (&acc)[2][2][4][2], const pg8::Unit& u, int wr, int wc, int fr, int fq) const {
        int upm = u.pm, upn = u.pn; asm volatile("" : "+s"(upm), "+s"(upn));
#pragma unroll
        for (int ai = 0; ai < 2; ++ai)
#pragma unroll
            for (int m = 0; m < 4; ++m)
#pragma unroll
                for (int bj = 0; bj < 2; ++bj) { const int row = upm * 256 + ai * 128 + wr * 64 + m * 16 + fr, c0 = (upn & 3) * 256 + bj * 128 + wc * 32 + 8 * fq;
                    float v[8] = {acc[ai][bj][m][0][0], acc[ai][bj][m][0][1], acc[ai][bj][m][0][2], acc[ai][bj][m][0][3], acc[ai][bj][m][1][0], acc[ai][bj][m][1][1], acc[ai][bj][m][1][2], acc[ai][bj][m][1][3]};
                    *(GAS u32x4*)((bf16_t*)(p.ws + WS_MIX) + (size_t)row * DM + c0) = pk8(v); }
    }
};
__device__ __forceinline__ void run_gemm_none(PG8_LAS unsigned char* lds, const P& p, size_t a_off, size_t b_off, int M, int N, int K, int wave) {
    pg8::Gemm g{(const bf16_t*)(p.ws + a_off), (const bf16_t*)(p.ws + b_off), M, N, K};
    pg8::StaticOrder So; So.init(M, N, (int)gridDim.x, (int)blockIdx.x);
    EpiNone E{p};
    pg8::gemm_phase<EpiNone, pg8::StaticOrder, true, true>(lds, g, So, E, wave);
}
struct EpiFinal {
    static constexpr bool PERM = true, AFTER_DRAIN = true;
    P p;
    __device__ __forceinline__ void operator()(const f32x4 (&)[2][2][4][2], const pg8::Unit&, int, int, int, int) const {}
    __device__ __forceinline__ void fused(const f32x4 (&acc_)[2][2][4][2], const pg8::Unit& u, int wr, int wc, int fr, int fq, PG8_LAS unsigned char* lds, int wid, int lane) const {
        f32x4 (&acc)[2][2][4][2] = const_cast<f32x4 (&)[2][2][4][2]>(acc_);
        P p = this->p; asm volatile("" : "+s"(p.ws));
        int upm = u.pm, upn = u.pn; asm volatile("" : "+s"(upm), "+s"(upn));
        PG8_LAS float* part = (PG8_LAS float*)lds;
        PG8_LAS float* rs = part + 1024;
        const int tid = wid * 64 + lane;
#pragma unroll
        for (int ai = 0; ai < 2; ++ai)
#pragma unroll
            for (int m = 0; m < 4; ++m) {
                const int rl = ai * 128 + wr * 64 + m * 16 + fr, row = upm * 256 + rl; float ss = 0.f;
#pragma unroll
                for (int bj = 0; bj < 2; ++bj) { const int c0 = upn * 256 + bj * 128 + wc * 32 + 8 * fq; float r[8];
                    unpk8(*(const GAS u32x4*)((const bf16_t*)(p.ws + WS_XB) + (size_t)row * DM + c0), r);
#pragma unroll
                    for (int j = 0; j < 4; ++j) { acc[ai][bj][m][0][j] += r[j]; acc[ai][bj][m][1][j] += r[4 + j]; ss += acc[ai][bj][m][0][j] * acc[ai][bj][m][0][j] + acc[ai][bj][m][1][j] * acc[ai][bj][m][1][j]; } }
                ss += __shfl_xor(ss, 16); ss += __shfl_xor(ss, 32);
                if (fq == 0) part[rl * 4 + wc] = ss;
            }
        __syncthreads();
        GAS unsigned* X = (GAS unsigned*)(p.ws + WS_MISC + MISC_FINX) + (size_t)upm * 1024;
        if (tid < 256) { const float s = (part[tid * 4] + part[tid * 4 + 1]) + (part[tid * 4 + 2] + part[tid * 4 + 3]);
            __hip_atomic_store(X + upn * 256 + tid, __float_as_uint(s), __ATOMIC_RELAXED, __HIP_MEMORY_SCOPE_AGENT); }
        asm volatile("s_waitcnt vmcnt(0)" ::: "memory");
        __syncthreads();
        if (tid == 0) { GAS unsigned* cnt = (GAS unsigned*)(p.ws + WS_CTL) + CW_FIN + 64 * upm;
            __hip_atomic_fetch_add(cnt, 1u, __ATOMIC_RELAXED, __HIP_MEMORY_SCOPE_AGENT);
            unsigned sp = 0; while (__hip_atomic_load(cnt, __ATOMIC_RELAXED, __HIP_MEMORY_SCOPE_AGENT) < 4u && ++sp < (1u << 22)) __builtin_amdgcn_s_sleep(1); }
        __syncthreads();
        if (tid < 256) { float s = 0.f;
#pragma unroll
            for (int o = 0; o < 4; ++o) s += __uint_as_float(__hip_atomic_load(X + o * 256 + tid, __ATOMIC_RELAXED, __HIP_MEMORY_SCOPE_AGENT));
            rs[tid] = 1.0f / sqrtf(s / (float)DM + EPS); }
        __syncthreads();
#pragma unroll
        for (int ai = 0; ai < 2; ++ai)
#pragma unroll
            for (int m = 0; m < 4; ++m) {
                const int rl = ai * 128 + wr * 64 + m * 16 + fr, row = upm * 256 + rl; const float rr = rs[rl];
#pragma unroll
                for (int bj = 0; bj < 2; ++bj) { const int c0 = upn * 256 + bj * 128 + wc * 32 + 8 * fq;
                    const f32x4 g0 = *(const GAS f32x4*)(p.norm_final + c0), g1 = *(const GAS f32x4*)(p.norm_final + c0 + 4);
                    GAS f32x4* o = (GAS f32x4*)(p.out + (size_t)row * DM + c0);
                    o[0] = (f32x4){acc[ai][bj][m][0][0] * rr * g0.x, acc[ai][bj][m][0][1] * rr * g0.y, acc[ai][bj][m][0][2] * rr * g0.z, acc[ai][bj][m][0][3] * rr * g0.w};
                    o[1] = (f32x4){acc[ai][bj][m][1][0] * rr * g1.x, acc[ai][bj][m][1][1] * rr * g1.y, acc[ai][bj][m][1][2] * rr * g1.z, acc[ai][bj][m][1][3] * rr * g1.w}; }
            }
    }
};
__device__ __forceinline__ void run_gemm_final(PG8_LAS unsigned char* lds, const P& p, size_t a_off, size_t b_off, int wave) {
    pg8::Gemm g{(const bf16_t*)(p.ws + a_off), (const bf16_t*)(p.ws + b_off), T, DM, DFF};
    pg8::StaticOrder So; So.init(T, DM, (int)gridDim.x, (int)blockIdx.x);
    EpiFinal E{p};
    pg8::gemm_phase<EpiFinal, pg8::StaticOrder, true, true>(lds, g, So, E, wave);
}
template <int EPI> __device__ __forceinline__ void run_gemm(PG8_LAS unsigned char* lds, const P& p, int layer, size_t a_off, size_t b_off, int M, int N, int K, int wave, int col_off = 0) {
    pg8::Gemm g{(const bf16_t*)(p.ws + a_off), (const bf16_t*)(p.ws + b_off), M, N, K};
    pg8::StaticOrder So; So.init(M, N, (int)gridDim.x, (int)blockIdx.x);
    EpiX<EPI> E{p, layer, col_off, nullptr};
    if (EpiX<EPI>::SCALED && gridDim.x == 256) {
        pg8::Unit u0; if (So.next(0, u0)) { row_scale_table<EPI>(p, u0.pm, lds, wave); E.rt = (PG8_LAS const float*)(lds + RT_OFF); } }
    pg8::gemm_phase<EpiX<EPI>, pg8::StaticOrder, true, true>(lds, g, So, E, wave);
}

struct OneUnit {
    pg8::Unit u;
    __device__ __forceinline__ bool next(int i, pg8::Unit& o) const { if (i) return false; o = u; return true; }
    __device__ __forceinline__ void a_ready(const pg8::Unit&) const {}
    __device__ __forceinline__ void done(const pg8::Unit&) const {}
};
__device__ __forceinline__ void run_gemm_unit(PG8_LAS unsigned char* lds, const P& p, int layer, int kind, int pm, int pn, int wave) {
    OneUnit So; So.u.pm = pm; So.u.pn = pn;
    if (kind == 0) { pg8::Gemm g{(const bf16_t*)(p.ws + WS_CQ), (const bf16_t*)(p.ws + WS_WUQ + layer * SZ_WUQ), T, NQ_UP, Q_LORA};
        row_scale_table<EPI_QUP>(p, pm, lds, wave);
        EpiX<EPI_QUP> E{p, layer, 0, (PG8_LAS const float*)(lds + RT_OFF)}; pg8::gemm_phase<EpiX<EPI_QUP>, OneUnit, true, true>(lds, g, So, E, wave); }
    else if (kind == 1) { pg8::Gemm g{(const bf16_t*)(p.ws + WS_CKV), (const bf16_t*)(p.ws + WS_WUKV + layer * SZ_WUKV), T, NKV_UP, KV_LORA};
        row_scale_table<EPI_KVUP>(p, pm, lds, wave);
        EpiX<EPI_KVUP> E{p, layer, 0, (PG8_LAS const float*)(lds + RT_OFF)}; pg8::gemm_phase<EpiX<EPI_KVUP>, OneUnit, true, true>(lds, g, So, E, wave); }
    else { pg8::Gemm g{(const bf16_t*)(p.ws + WS_XB), (const bf16_t*)(p.ws + WS_WIN + layer * SZ_WIN + (size_t)2048 * DM * 2), T, 256, DM};
        row_scale_table<EPI_IN8>(p, pm, lds, wave);
        EpiX<EPI_IN8> E{p, layer, 2048, (PG8_LAS const float*)(lds + RT_OFF)}; pg8::gemm_phase<EpiX<EPI_IN8>, OneUnit, true, true>(lds, g, So, E, wave); }
}
typedef short s16x4 __attribute__((ext_vector_type(4)));
typedef short v4i16_t __attribute__((ext_vector_type(4)));
typedef LAS const char* lds_cptr;
#define MFMA32(a, b, c) __builtin_amdgcn_mfma_f32_32x32x16_bf16(a, b, c, 0, 0, 0)
#define MFMA16(a, b, c) __builtin_amdgcn_mfma_f32_16x16x32_bf16(a, b, c, 0, 0, 0)
__device__ __forceinline__ int crow(int r, int hi) { return (r & 3) + 8 * (r >> 2) + 4 * hi; }
__device__ __forceinline__ unsigned cvtpk(float lo, float hi) { unsigned r; asm("v_cvt_pk_bf16_f32 %0, %1, %2" : "=v"(r) : "v"(lo), "v"(hi)); return r; }
__device__ __forceinline__ void glds16(const void* g, unsigned lds_base) {
    unsigned sv; asm volatile("s_mov_b32 %0, m0\n\ts_mov_b32 m0, %2\n\ts_nop 0\n\tglobal_load_lds_dwordx4 %1, off\n\ts_mov_b32 m0, %0" : "=&s"(sv) : "v"(g), "s"(lds_base) : "memory"); }
__device__ __forceinline__ s16x4 vtr(lds_cptr p) { return __builtin_bit_cast(s16x4, __builtin_amdgcn_ds_read_tr16_b64_v4i16((LAS v4i16_t*)p)); }
__device__ __forceinline__ float xhalf_max(float m) { auto rr = __builtin_amdgcn_permlane32_swap(__float_as_uint(m), __float_as_uint(m), false, false); return fmaxf(__uint_as_float(rr[0]), __uint_as_float(rr[1])); }
__device__ __forceinline__ float xhalf_sum(float m) { auto rr = __builtin_amdgcn_permlane32_swap(__float_as_uint(m), __float_as_uint(m), false, false); return __uint_as_float(rr[0]) + __uint_as_float(rr[1]); }
__device__ __forceinline__ float rowmax32(const f32x16& a, const f32x16& b) {
    float m = fmaxf(a[0], b[0]);
#pragma unroll
    for (int r = 1; r < 16; ++r) m = fmaxf(m, fmaxf(a[r], b[r]));
    return xhalf_max(m); }
#define WAIT_BAR0() asm volatile("s_waitcnt vmcnt(0) lgkmcnt(0)\n\ts_barrier" ::: "memory")

constexpr int AT_KOFF = 0, AT_VOFF = 2 * 12288, AT_LUT = AT_VOFF + 2 * 8192, AT_END = AT_LUT + 1024;
constexpr size_t MISC_PMIN32 = 8192, MISC_PMAX64 = 12288;
constexpr float NEG_INF = -__builtin_huge_valf();

template <int VAR> __device__ __forceinline__ void attn_unit(const P& p, int layer, int b, int h, int qb, LAS unsigned char* lds, int wave) {
    constexpr int NCH = (VAR == 0) ? 12 : 8, ND0 = (VAR == 0) ? 6 : (VAR == 2 ? 4 : 2), NC = (VAR == 1) ? 2 : 1;
    constexpr int KSLOT = 12288, VSLOT = 8192;
    const int tid = phase_tid(wave), lane = tid & 63, r32 = lane & 31, hi = lane >> 5, wid = wave;
    const int q0 = qb * 256, NT = 4 * (qb + 1);
    const int qidx = q0 + wid * 32 + r32, qrow = b * S + qidx;
    const unsigned char* ws = p.ws; asm volatile("" : "+s"(ws));
    const unsigned lds0 = (unsigned)(uintptr_t)lds;
    const char* ksrc; const char* ksrc2 = nullptr; const char* vsrc; size_t kstep2 = 0;
    if (VAR == 0) { ksrc = (const char*)(ws + WS_KN) + ((size_t)(b * 8 + h) * NT64 * 8 + wid) * 1024 + lane * 16;
                    ksrc2 = (const char*)(ws + WS_KR) + ((size_t)b * NT64 * 4 + (wid & 3)) * 1024 + lane * 16; kstep2 = 4096;
                    vsrc = (const char*)(ws + WS_VA) + (size_t)(b * 8 + h) * NT64 * 8192 + wid * 1024 + lane * 16; }
    else if (VAR == 1) { ksrc = (const char*)(ws + WS_KC) + ((size_t)(b * 4 + h) * NT64 * 8 + wid) * 1024 + lane * 16;
                         vsrc = (const char*)(ws + WS_VC) + (size_t)(b * 4 + h) * NT64 * 8192 + wid * 1024 + lane * 16; }
    else { ksrc = (const char*)(ws + WS_KB) + ((size_t)b * NT64 * 8 + wid) * 1024 + lane * 16;
           vsrc = (const char*)(ws + WS_VB) + (size_t)b * NT64 * 8192 + wid * 1024 + lane * 16; }
    const unsigned kdst = lds0 + AT_KOFF + wid * 1024, kdst2 = lds0 + AT_KOFF + (8 + (wid & 3)) * 1024, vdst = lds0 + AT_VOFF + wid * 1024;
#define DMA_TILE(t, slot) do { glds16(ksrc + (size_t)(t) * 8192, (unsigned)__builtin_amdgcn_readfirstlane(kdst + (slot) * KSLOT)); \
        if (VAR == 0 && wid < 4) glds16(ksrc2 + (size_t)(t) * kstep2, (unsigned)__builtin_amdgcn_readfirstlane(kdst2 + (slot) * KSLOT)); \
        glds16(vsrc + (size_t)(t) * 8192, (unsigned)__builtin_amdgcn_readfirstlane(vdst + (slot) * VSLOT)); } while (0)
    DMA_TILE(0, 0);
    bf16x8 qf[NC * ND0];
    {
        const bf16_t* qp;
        if (VAR == 0) qp = (const bf16_t*)(ws + WS_QA) + (size_t)qrow * NQ_UP + h * 96 + 8 * hi;
        else if (VAR == 1) qp = (const bf16_t*)(ws + WS_QC) + (size_t)qrow * 256 + h * 64 + 8 * hi;
        else qp = (const bf16_t*)(ws + WS_QB) + (size_t)qrow * 256 + h * 64 + 8 * hi;
#pragma unroll
        for (int i = 0; i < NC * ND0; ++i) qf[i] = *(const GAS bf16x8*)(qp + 16 * i);
    }
    LAS float* lutl = (LAS float*)(lds + AT_LUT);
    int qpos = 0; float bfar = 0.f; int pminq = 0;
    if (VAR != 0) {
        const int hb = (VAR == 1) ? 4 + h : h;
        if (tid < 129) lutl[tid] = ((const float*)(ws + WS_MISC))[tid * 8 + hb];
        qpos = p.pos[qrow];
        bfar = ((const float*)(ws + WS_MISC))[128 * 8 + hb];
        pminq = ((const int*)(ws + WS_MISC + MISC_PMIN32))[(b * S + q0 + wid * 32) >> 5];
    }
    const int* pmax64 = (const int*)(ws + WS_MISC + MISC_PMAX64) + b * NT64;
    const unsigned* bmrow = (const unsigned*)(ws + WS_BM) + (size_t)qrow * 128;
    u32x2 bmw = {0u, 0u};
    if (VAR == 2) bmw = *(const GAS u32x2*)(bmrow);
    float m_run[NC], l_run[NC]; f32x16 oT[NC][2];
#pragma unroll
    for (int c = 0; c < NC; ++c) { m_run[c] = -1e30f; l_run[c] = 0.f; oT[c][0] = f32x16{}; oT[c][1] = f32x16{}; }
    const int vpoff = ((lane >> 4) & 1) * 32 + (lane & 3) * 8 + (4 * hi + ((lane & 15) >> 2)) * 64;
    const int kpoff = hi * 1024 + r32 * 16;

    for (int j = 0; j < NT; ++j) {
        WAIT_BAR0();
        if (j + 1 < NT) DMA_TILE(j + 1, (j + 1) & 1);
        u32x2 bmw_next = {0u, 0u};
        if (VAR == 2 && j + 1 < NT) bmw_next = *(const GAS u32x2*)(bmrow + 2 * (j + 1));
        const lds_cptr ks = (lds_cptr)lds + AT_KOFF + (j & 1) * KSLOT + kpoff;
        const lds_cptr vs = (lds_cptr)lds + AT_VOFF + (j & 1) * VSLOT + vpoff;
        bool far = true; float boff = 0.f;
        if (VAR != 0) { far = (pminq - pmax64[j]) >= 113; boff = far ? bfar : 0.f; }

#pragma unroll
        for (int c = 0; c < NC; ++c) {
            __builtin_amdgcn_sched_barrier(0);
            f32x16 s0 = f32x16{}, s1 = f32x16{};
#pragma unroll
            for (int d0 = 0; d0 < ND0; ++d0) {
                const bf16x8 ka = *(const LAS bf16x8*)(ks + c * 4096 + d0 * 2048), kb = *(const LAS bf16x8*)(ks + c * 4096 + d0 * 2048 + 512);
                s0 = MFMA32(ka, qf[c * ND0 + d0], s0); s1 = MFMA32(kb, qf[c * ND0 + d0], s1);
            }
            __builtin_amdgcn_sched_barrier(0);
            if (VAR != 0 && !far) {
#pragma unroll
                for (int g = 0; g < 4; ++g) {
                    const int kb0 = b * S + 64 * j + 8 * g + 4 * hi;
                    const int4 kp0 = *(const int4*)(p.pos + kb0), kp1 = *(const int4*)(p.pos + kb0 + 32);
                    const int k0[4] = {kp0.x, kp0.y, kp0.z, kp0.w}, k1[4] = {kp1.x, kp1.y, kp1.z, kp1.w};
#pragma unroll
                    for (int i = 0; i < 4; ++i) { int r0 = qpos - k0[i]; r0 = r0 < 0 ? 0 : (r0 > 128 ? 128 : r0); int r1 = qpos - k1[i]; r1 = r1 < 0 ? 0 : (r1 > 128 ? 128 : r1);
                        s0[4 * g + i] += lutl[r0]; s1[4 * g + i] += lutl[r1]; }
                    __builtin_amdgcn_sched_barrier(0);
                }
            }
            if (VAR != 2) { if (j >= NT - 4) {
#pragma unroll
                for (int r = 0; r < 16; ++r) { const int kv = 64 * j + crow(r, hi); if (kv > qidx) s0[r] = NEG_INF; if (kv + 32 > qidx) s1[r] = NEG_INF; } } }
            else {
#pragma unroll
                for (int r = 0; r < 16; ++r) { const int sh = crow(r, hi); if (!((bmw.x >> sh) & 1u)) s0[r] = NEG_INF; if (!((bmw.y >> sh) & 1u)) s1[r] = NEG_INF; } }
            u32x4 pw[4];
            const float tmax = rowmax32(s0, s1) + boff;
            const float m_new = fmaxf(m_run[c], tmax);
            if (__any(m_new > m_run[c])) {
                const float alpha = __builtin_amdgcn_exp2f(m_run[c] - m_new);
                l_run[c] *= alpha;
#pragma unroll
                for (int r = 0; r < 16; ++r) { oT[c][0][r] *= alpha; oT[c][1][r] *= alpha; }
                m_run[c] = m_new;
            }
            const float nm = boff - m_run[c];
            float rs = 0.f;
#pragma unroll
            for (int r = 0; r < 16; ++r) { s0[r] = __builtin_amdgcn_exp2f(s0[r] + nm); s1[r] = __builtin_amdgcn_exp2f(s1[r] + nm); rs += s0[r] + s1[r]; }
            l_run[c] += rs;
            pw[0] = (u32x4){cvtpk(s0[0], s0[1]), cvtpk(s0[2], s0[3]), cvtpk(s0[4], s0[5]), cvtpk(s0[6], s0[7])};
            pw[1] = (u32x4){cvtpk(s0[8], s0[9]), cvtpk(s0[10], s0[11]), cvtpk(s0[12], s0[13]), cvtpk(s0[14], s0[15])};
            pw[2] = (u32x4){cvtpk(s1[0], s1[1]), cvtpk(s1[2], s1[3]), cvtpk(s1[4], s1[5]), cvtpk(s1[6], s1[7])};
            pw[3] = (u32x4){cvtpk(s1[8], s1[9]), cvtpk(s1[10], s1[11]), cvtpk(s1[12], s1[13]), cvtpk(s1[14], s1[15])};
            __builtin_amdgcn_sched_barrier(0);
#pragma unroll
        for (int ksp = 0; ksp < 4; ++ksp) {
            __builtin_amdgcn_sched_barrier(0);
#pragma unroll
            for (int db = 0; db < 2; ++db) {
                const s16x4 vlo = vtr(vs + db * 4096 + ksp * 1024), vhi = vtr(vs + db * 4096 + ksp * 1024 + 512);
                const bf16x8 vf = (bf16x8){vlo[0], vlo[1], vlo[2], vlo[3], vhi[0], vhi[1], vhi[2], vhi[3]};
                oT[c][db] = MFMA32(vf, __builtin_bit_cast(bf16x8, pw[ksp]), oT[c][db]);
            }
        }
        }
        bmw = bmw_next;
    }
#undef DMA_TILE
    float o[2][16];
    if (VAR == 1) {
        const float* lp = p.diff_lambda + layer * 128; float d01 = 0.f, d23 = 0.f;
        for (int i = 0; i < 32; ++i) { d01 += lp[i] * lp[32 + i]; d23 += lp[64 + i] * lp[96 + i]; }
        const float lam_init = lam_init_of(layer), lam = expf(d01) - expf(d23) + lam_init;
        const float i0 = 1.0f / xhalf_sum(l_run[0]), i1 = lam / xhalf_sum(l_run[NC - 1]);
        float ss = 0.f;
#pragma unroll
        for (int db = 0; db < 2; ++db)
#pragma unroll
            for (int r = 0; r < 16; ++r) { const float v = oT[0][db][r] * i0 - oT[NC - 1][db][r] * i1; o[db][r] = v; ss += v * v; }
        ss = xhalf_sum(ss);
        const float rsn = 1.0f / sqrtf(ss / 64.f + EPS) * (1.f - lam_init);
        const float* g = p.diff_subln + layer * 64;
#pragma unroll
        for (int db = 0; db < 2; ++db)
#pragma unroll
            for (int r = 0; r < 16; ++r) o[db][r] *= rsn * g[32 * db + crow(r, hi)];
    } else {
        const float il = 1.0f / xhalf_sum(l_run[0]);
#pragma unroll
        for (int db = 0; db < 2; ++db)
#pragma unroll
            for (int r = 0; r < 16; ++r) o[db][r] = oT[0][db][r] * il;
    }
    bf16_t* mix = (bf16_t*)(ws + WS_MIX) + (size_t)qrow * DM + (VAR == 0 ? h * 64 : (VAR == 2 ? 512 + h * 64 : 768 + h * 64)) + 4 * hi;
#pragma unroll
    for (int db = 0; db < 2; ++db)
#pragma unroll
        for (int g = 0; g < 4; ++g) { u32x2 w; w.x = pk2(o[db][4 * g], o[db][4 * g + 1]); w.y = pk2(o[db][4 * g + 2], o[db][4 * g + 3]); *(GAS u32x2*)(mix + 32 * db + 8 * g) = w; }
    WAIT_BAR0();
}
#define SBAR() __builtin_amdgcn_sched_barrier(0)
#define PIN(x) asm volatile("" : "+v"(x))
constexpr int A2_KSLOT = 12288, A2_VSLOT = 8192, A2_KOFF = 0, A2_VOFF = 3 * A2_KSLOT, A2_LUT = A2_VOFF + 3 * A2_VSLOT, A2_END = A2_LUT + 1024;
constexpr float A2_THR = 8.f;
__device__ __forceinline__ void wait_bar_n(int n) {
    if (n == 0) asm volatile("s_waitcnt vmcnt(0) lgkmcnt(0)\n\ts_barrier" ::: "memory");
    else if (n == 1) asm volatile("s_waitcnt vmcnt(1) lgkmcnt(0)\n\ts_barrier" ::: "memory");
    else if (n == 2) asm volatile("s_waitcnt vmcnt(2) lgkmcnt(0)\n\ts_barrier" ::: "memory");
    else asm volatile("s_waitcnt vmcnt(3) lgkmcnt(0)\n\ts_barrier" ::: "memory");
}
__device__ __forceinline__ float rowmax32f(const f32x16& p0, const f32x16& p1) {
#define MX3(a, b, c) __builtin_fmaxf(__builtin_fmaxf((a), (b)), (c))
    float a = MX3(p0[0], p0[1], p1[0]), b = MX3(p0[2], p0[3], p1[1]); a = MX3(a, p1[2], p1[3]);
#pragma unroll
    for (int r = 4; r < 16; r += 4) { a = MX3(a, p0[r], p0[r + 1]); b = MX3(b, p0[r + 2], p0[r + 3]); a = MX3(a, p1[r], p1[r + 1]); b = MX3(b, p1[r + 2], p1[r + 3]); }
#undef MX3
    return xhalf_max(__builtin_fmaxf(a, b)); }

template <int VAR> __device__ __forceinline__ void attn_unit_p(const P& p, int layer, int b, int h, int qb, LAS unsigned char* lds, int wave) {
    static_assert(VAR == 0 || VAR == 2, "single-map variants");
    constexpr int ND0 = (VAR == 0) ? 6 : 4, NQK = 2 * ND0;
    constexpr bool TUPLE = true;
    constexpr bool NEGM = false;
    const int tid = phase_tid(wave), lane = tid & 63, r32 = lane & 31, hi = lane >> 5, wid = wave;
    const int q0 = qb * 256, NT = 4 * (qb + 1);
    const int qidx = q0 + wid * 32 + r32, qrow = b * S + qidx;
    const unsigned char* ws = p.ws; asm volatile("" : "+s"(ws));
    const unsigned lds0 = (unsigned)(uintptr_t)lds;
    const char* ksrc; const char* ksrc2 = nullptr; const char* vsrc;
    if (VAR == 0) { ksrc = (const char*)(ws + WS_KN) + ((size_t)(b * 8 + h) * NT64 * 8 + wid) * 1024 + lane * 16;
                    ksrc2 = (const char*)(ws + WS_KR) + ((size_t)b * NT64 * 4 + (wid & 3)) * 1024 + lane * 16;
                    vsrc = (const char*)(ws + WS_VA) + (size_t)(b * 8 + h) * NT64 * 8192 + wid * 1024 + lane * 16; }
    else { ksrc = (const char*)(ws + WS_KB) + ((size_t)b * NT64 * 8 + wid) * 1024 + lane * 16;
           vsrc = (const char*)(ws + WS_VB) + (size_t)b * NT64 * 8192 + wid * 1024 + lane * 16; }
    const unsigned kdst = lds0 + A2_KOFF + wid * 1024, kdst2 = lds0 + A2_KOFF + (8 + (wid & 3)) * 1024, vdst = lds0 + A2_VOFF + wid * 1024;
    const bool k2 = (VAR == 0) && (wid < 4);
    const int nkd = k2 ? 2 : 1;
#define DMA_K(t, slot) do { glds16(ksrc + (size_t)(t) * 8192, (unsigned)__builtin_amdgcn_readfirstlane(kdst + (slot) * A2_KSLOT)); \
        if (k2) glds16(ksrc2 + (size_t)(t) * 4096, (unsigned)__builtin_amdgcn_readfirstlane(kdst2 + (slot) * A2_KSLOT)); } while (0)
#define DMA_V(t, slot) glds16(vsrc + (size_t)(t) * 8192, (unsigned)__builtin_amdgcn_readfirstlane(vdst + (slot) * A2_VSLOT))
    DMA_K(0, 0); DMA_V(0, 0); DMA_K(1, 1); DMA_K(2, 2);
    bf16x8 qf[ND0];
    {
        const bf16_t* qp = (VAR == 0) ? (const bf16_t*)(ws + WS_QA) + (size_t)qrow * NQ_UP + h * 96 + 8 * hi : (const bf16_t*)(ws + WS_QB) + (size_t)qrow * 256 + h * 64 + 8 * hi;
#pragma unroll
        for (int i = 0; i < ND0; ++i) qf[i] = *(const GAS bf16x8*)(qp + 16 * i);
    }
    LAS float* lutl = (LAS float*)(lds + A2_LUT);
    float bfar = 0.f;
    if (VAR == 2) {
        if (tid < 252) { int ri = tid - 64; ri = ri < 0 ? 0 : (ri > 128 ? 128 : ri); lutl[tid] = ((const float*)(ws + WS_MISC))[ri * 8 + h]; }
        bfar = ((const float*)(ws + WS_MISC))[128 * 8 + h];
    }
    const unsigned* bmrow = (const unsigned*)(ws + WS_BM) + (size_t)qrow * 128;
    const lds_cptr vp0 = (lds_cptr)lds + A2_VOFF + ((lane >> 4) & 1) * 32 + (lane & 3) * 8 + (4 * hi + ((lane & 15) >> 2)) * 64;
    const lds_cptr kp0 = (lds_cptr)lds + A2_KOFF + hi * 1024 + r32 * 16;
    float mhat = 0.f, l_reg = 0.f, fresc = 1.f; bool resc = false;
    f32x16 oT[2]; oT[0] = f32x16{}; oT[1] = f32x16{};
    f32x16 negm;
    f32x16 pA0, pA1, pB0, pB1; bf16x8 kf[NQK]; s16x4 vlo[8], vhi[8]; u32x4 pw0, pw1, pw2, pw3;
    int sl_prev = 0, sl_cur = 0, sl_next = 1;
#define ROT() do { sl_prev = sl_cur; sl_cur = sl_next; sl_next = (sl_next == 2) ? 0 : sl_next + 1; } while (0)
#define KLOAD(slot, d0) do { kf[2 * (d0)] = *(const LAS bf16x8*)(kp0 + (slot) * A2_KSLOT + (d0) * 2048); kf[2 * (d0) + 1] = *(const LAS bf16x8*)(kp0 + (slot) * A2_KSLOT + (d0) * 2048 + 512); } while (0)
#define FILLNEG() do { if (NEGM) { const float nv_ = bfar - mhat; _Pragma("unroll") for (int r = 0; r < 16; ++r) negm[r] = nv_; PIN(negm); } } while (0)
#define NEARFILL(C0, C1, t) do { \
        int bb_ = qidx - 64 * (t) - 4 * hi; bb_ = bb_ > 187 ? 187 : (bb_ < -5 ? -5 : bb_); const LAS float* lp_ = lutl + (bb_ + 5); \
        _Pragma("unroll") for (int r = 0; r < 16; ++r) { const int off_ = 8 * (r >> 2) + (r & 3); C0[r] = lp_[59 - off_] - mhat; C1[r] = lp_[27 - off_] - mhat; } \
        PIN(C0); PIN(C1); } while (0)
#define FIXUP(C0, C1, t, MASK, BW) do { \
        if (VAR == 2) { \
            const u32x2 bw_ = (BW); \
            _Pragma("unroll") for (int r = 0; r < 16; ++r) { const int sh = crow(r, hi); if (!((bw_.x >> sh) & 1u)) C0[r] = NEG_INF; if (!((bw_.y >> sh) & 1u)) C1[r] = NEG_INF; if ((r & 3) == 3) { PIN(C0); PIN(C1); SBAR(); } } \
        } else if (MASK) { \
            _Pragma("unroll") for (int r = 0; r < 16; ++r) { const int kv = 64 * (t) + crow(r, hi); if (kv > qidx) C0[r] = NEG_INF; if (kv + 32 > qidx) C1[r] = NEG_INF; } } \
    } while (0)
    u32x2 bmw = {0u, 0u}, bmw1 = {0u, 0u};
    if (VAR == 2) { bmw = *(const GAS u32x2*)(bmrow); bmw1 = *(const GAS u32x2*)(bmrow + 2); }
    wait_bar_n(0);
#pragma unroll
    for (int d0 = 0; d0 < ND0; ++d0) KLOAD(0, d0);
    {
        mhat = 0.f;
        f32x16 z = f32x16{};
        pA0 = z; pA1 = z;
        const bool near0 = (VAR == 2) && (((q0 + wid * 32) - 63) < 113);
        if (near0) NEARFILL(pA0, pA1, 0);
        const float b0 = (VAR == 2 && !near0) ? bfar : 0.f;
#pragma unroll
        for (int d0 = 0; d0 < ND0; ++d0) { pA0 = MFMA32(kf[2 * d0], qf[d0], pA0); pA1 = MFMA32(kf[2 * d0 + 1], qf[d0], pA1); }
        FIXUP(pA0, pA1, 0, (NT == 4), bmw);
        const float rm = rowmax32f(pA0, pA1) + b0;
        mhat = (VAR == 2) ? __builtin_fmaxf(rm, -40.f) : rm;
        { const float nm0 = b0 - mhat;
#pragma unroll
        for (int r = 0; r < 16; ++r) { pA0[r] = __builtin_amdgcn_exp2f(pA0[r] + nm0); pA1[r] = __builtin_amdgcn_exp2f(pA1[r] + nm0); } }
        FILLNEG();
        if (VAR == 0) { const float cv_ = bfar - mhat; _Pragma("unroll") for (int r = 0; r < 16; ++r) { pB0[r] = cv_; pB1[r] = cv_; } }
    }
    if (NT > 1) {
#pragma unroll
        for (int d0 = 0; d0 < ND0; ++d0) KLOAD(1, d0);
    }
    wait_bar_n(0);
    if (VAR == 2) bmw = bmw1;
    if (3 < NT) DMA_K(3, 0);
    DMA_V(1, 1); ROT();

#define PKW(P, i) cvtpk(P[i], P[i + 1])
#define PAF(k) __builtin_bit_cast(bf16x8, pw##k)
#define VFR(i) (bf16x8){vlo[i][0], vlo[i][1], vlo[i][2], vlo[i][3], vhi[i][0], vhi[i][1], vhi[i][2], vhi[i][3]}
#define VRD(i) do { vlo[i] = vtr(vp_ + (((i) >> 2) * 4096 + ((i) & 3) * 1024)); vhi[i] = vtr(vp_ + (((i) >> 2) * 4096 + ((i) & 3) * 1024 + 512)); } while (0)
#define EX4N(X, i, nm) do { X[i] = __builtin_amdgcn_exp2f(X[i] + (nm)); X[i + 1] = __builtin_amdgcn_exp2f(X[i + 1] + (nm)); X[i + 2] = __builtin_amdgcn_exp2f(X[i + 2] + (nm)); X[i + 3] = __builtin_amdgcn_exp2f(X[i + 3] + (nm)); PIN(X); } while (0)
#define EX4(X, i) do { X[i] = __builtin_amdgcn_exp2f(X[i]); X[i + 1] = __builtin_amdgcn_exp2f(X[i + 1]); X[i + 2] = __builtin_amdgcn_exp2f(X[i + 2]); X[i + 3] = __builtin_amdgcn_exp2f(X[i + 3]); PIN(X); } while (0)
#define GAPA(C0, C1, P0, P1, g) do { \
        if ((g) < 8) { VRD(((g) >> 1) + 4 * ((g) & 1)); SBAR(); }                                    \
        if ((g) >= 2 || near_ || !NEGM) { if (((g) & 1) == 0) C0 = MFMA32(kf[g], qf[(g) >> 1], C0); else C1 = MFMA32(kf[g], qf[(g) >> 1], C1); } \
        else { if (((g) & 1) == 0) C0 = MFMA32(kf[g], qf[(g) >> 1], negm); else C1 = MFMA32(kf[g], qf[(g) >> 1], negm); } \
        if ((g) < 8) { const int a_ = 4 * (g); \
            if (a_ < 16) { sacc += P0[a_]; sacc += P0[a_ + 1]; sacc += P0[a_ + 2]; sacc += P0[a_ + 3]; } else { sacc += P1[a_ - 16]; sacc += P1[a_ - 15]; sacc += P1[a_ - 14]; sacc += P1[a_ - 13]; } \
            if ((g) == 0) { pw0[0] = PKW(P0, 0); pw0[1] = PKW(P0, 2); PIN(pw0); } if ((g) == 1) { pw0[2] = PKW(P0, 4); pw0[3] = PKW(P0, 6); PIN(pw0); } \
            if ((g) == 2) { pw1[0] = PKW(P0, 8); pw1[1] = PKW(P0, 10); PIN(pw1); } if ((g) == 3) { pw1[2] = PKW(P0, 12); pw1[3] = PKW(P0, 14); PIN(pw1); } \
            if ((g) == 4) { pw2[0] = PKW(P1, 0); pw2[1] = PKW(P1, 2); PIN(pw2); } if ((g) == 5) { pw2[2] = PKW(P1, 4); pw2[3] = PKW(P1, 6); PIN(pw2); } \
            if ((g) == 6) { pw3[0] = PKW(P1, 8); pw3[1] = PKW(P1, 10); PIN(pw3); } if ((g) == 7) { pw3[2] = PKW(P1, 12); pw3[3] = PKW(P1, 14); PIN(pw3); } \
            PIN(sacc); } \
        if (VAR == 0 && (g) >= 8) { const float cvn_ = bfar - mhat; const int e_ = 4 * ((g) - 8);                                       \
            P0[e_] = cvn_; P0[e_ + 1] = cvn_; P0[e_ + 2] = cvn_; P0[e_ + 3] = cvn_; P1[e_] = cvn_; P1[e_ + 1] = cvn_; P1[e_ + 2] = cvn_; P1[e_ + 3] = cvn_; PIN(P0); PIN(P1); } \
        SBAR(); } while (0)
#define STEP(C0, C1, P0, P1, t, MASK, GK, GV, GL) do { SBAR(); \
        const lds_cptr vp_ = vp0 + sl_prev * A2_VSLOT; float sacc = 0.f; \
        const bool near_ = (VAR == 2) && (((q0 + wid * 32) - (64 * (t) + 63)) < 113); \
        if (near_) NEARFILL(C0, C1, t); \
        else if (VAR == 2) {                                       \
            const unsigned cvb_ = __float_as_uint(bfar - mhat), wx_ = bmw.x >> (4 * hi), wy_ = bmw.y >> (4 * hi); \
            _Pragma("unroll") for (int r = 0; r < 16; ++r) { const int cb_ = (r & 3) + 8 * (r >> 2); \
                const unsigned m0_ = (unsigned)__builtin_amdgcn_sbfe((int)wx_, cb_, 1), m1_ = (unsigned)__builtin_amdgcn_sbfe((int)wy_, cb_, 1); \
                C0[r] = __uint_as_float((m0_ & cvb_) | (~m0_ & 0xff800000u)); C1[r] = __uint_as_float((m1_ & cvb_) | (~m1_ & 0xff800000u)); } \
            PIN(C0); PIN(C1); } \
        else if (!NEGM && VAR != 0) { const float cv_ = bfar - mhat; _Pragma("unroll") for (int r = 0; r < 16; ++r) { C0[r] = cv_; C1[r] = cv_; } PIN(C0); PIN(C1); } \
        u32x2 bwn_ = {0u, 0u}; if (VAR == 2 && (t) + 1 < NT) bwn_ = *(const GAS u32x2*)(bmrow + 2 * ((t) + 1));     \
        _Pragma("unroll") for (int g_ = 0; g_ < NQK; ++g_) GAPA(C0, C1, P0, P1, g_); \
        l_reg += sacc; \
        if (VAR != 2 || near_) FIXUP(C0, C1, t, MASK, bmw); \
        bmw = bwn_; \
        if (GK) DMA_K((t) + 3, sl_cur); if (GV) DMA_V((t) + 1, sl_next);                            \
        float nm_ = TUPLE ? 0.f : ((near_ ? 0.f : bfar) - mhat);                                    \
        { const float rm = rowmax32f(C0, C1) + nm_; resc = false;                                    \
          if (__builtin_expect(__any(rm > A2_THR), 0)) { const float dl = __builtin_fmaxf(rm, 0.f); mhat += dl; fresc = __builtin_amdgcn_exp2f(-dl); l_reg *= fresc; resc = true; \
              if (TUPLE) { _Pragma("unroll") for (int r = 0; r < 16; ++r) { C0[r] -= dl; C1[r] -= dl; } FILLNEG(); } else nm_ -= dl; \
              if (VAR == 0) { const float cvn_ = bfar - mhat; _Pragma("unroll") for (int r = 0; r < 16; ++r) { P0[r] = cvn_; P1[r] = cvn_; } PIN(P0); PIN(P1); } } } \
        SBAR(); \
        _Pragma("unroll") for (int i_ = 0; i_ < 8; ++i_) { \
            if (GL && i_ >= 1 && i_ - 1 < ND0) { KLOAD(sl_next, i_ - 1); SBAR(); } \
            { const int ks_ = i_ >> 1, db_ = i_ & 1, vi_ = 4 * db_ + ks_; \
              const bf16x8 pa_ = (ks_ == 0) ? PAF(0) : (ks_ == 1) ? PAF(1) : (ks_ == 2) ? PAF(2) : PAF(3); \
              oT[db_] = MFMA32(VFR(vi_), pa_, oT[db_]); } \
            if (TUPLE) { if (i_ < 4) EX4(C0, 4 * i_); else EX4(C1, 4 * (i_ - 4)); } else { if (i_ < 4) EX4N(C0, 4 * i_, nm_); else EX4N(C1, 4 * (i_ - 4), nm_); } \
            SBAR(); } \
    } while (0)
#define RESC() do { if (resc) { _Pragma("unroll") for (int r = 0; r < 16; ++r) { oT[0][r] *= fresc; oT[1][r] *= fresc; } } } while (0)
    int t = 1;
    for (; t + 5 < NT; t += 2) {
        STEP(pB0, pB1, pA0, pA1, t, false, true, true, true);     wait_bar_n(nkd + 1); RESC(); ROT();
        STEP(pA0, pA1, pB0, pB1, t + 1, false, true, true, true); wait_bar_n(nkd + 1); RESC(); ROT();
    }
#define ENDW(tt) do { if ((tt) + 3 < NT) wait_bar_n(nkd + 1); else if ((tt) + 2 < NT) wait_bar_n(1); else wait_bar_n(0); } while (0)
    for (; t + 1 < NT; t += 2) {
        STEP(pB0, pB1, pA0, pA1, t, true, (t + 3 < NT), (t + 1 < NT), (t + 1 < NT));         ENDW(t);     RESC(); ROT();
        STEP(pA0, pA1, pB0, pB1, t + 1, true, (t + 4 < NT), (t + 2 < NT), (t + 2 < NT));     ENDW(t + 1); RESC(); ROT();
    }
    STEP(pB0, pB1, pA0, pA1, NT - 1, true, false, false, false); RESC();
    { float sacc = 0.f;
#pragma unroll
      for (int r = 0; r < 16; ++r) sacc += pB0[r] + pB1[r];
      l_reg += sacc;
      pw0 = (u32x4){PKW(pB0, 0), PKW(pB0, 2), PKW(pB0, 4), PKW(pB0, 6)}; pw1 = (u32x4){PKW(pB0, 8), PKW(pB0, 10), PKW(pB0, 12), PKW(pB0, 14)};
      pw2 = (u32x4){PKW(pB1, 0), PKW(pB1, 2), PKW(pB1, 4), PKW(pB1, 6)}; pw3 = (u32x4){PKW(pB1, 8), PKW(pB1, 10), PKW(pB1, 12), PKW(pB1, 14)};
      const lds_cptr vp_ = vp0 + sl_cur * A2_VSLOT;
#pragma unroll
      for (int i = 0; i < 8; ++i) VRD(i);
#pragma unroll
      for (int ks = 0; ks < 4; ++ks) { const bf16x8 pa_ = (ks == 0) ? PAF(0) : (ks == 1) ? PAF(1) : (ks == 2) ? PAF(2) : PAF(3);
          oT[0] = MFMA32(VFR(ks), pa_, oT[0]); oT[1] = MFMA32(VFR(4 + ks), pa_, oT[1]); } }
    const float il = 1.0f / xhalf_sum(l_reg);
    bf16_t* mix = (bf16_t*)(ws + WS_MIX) + (size_t)qrow * DM + (VAR == 0 ? h * 64 : 512 + h * 64) + 4 * hi;
#pragma unroll
    for (int db = 0; db < 2; ++db)
#pragma unroll
        for (int g = 0; g < 4; ++g) { u32x2 w; w.x = pk2(oT[db][4 * g] * il, oT[db][4 * g + 1] * il); w.y = pk2(oT[db][4 * g + 2] * il, oT[db][4 * g + 3] * il); *(GAS u32x2*)(mix + 32 * db + 8 * g) = w; }
    wait_bar_n(0);
#undef DMA_K
#undef DMA_V
#undef ROT
#undef KLOAD
#undef FILLNEG
#undef FIXUP
#undef NEARFILL
#undef PKW
#undef PAF
#undef VFR
#undef VRD
#undef EX4
#undef EX4N
#undef GAPA
#undef STEP
#undef RESC
#undef ENDW
}
constexpr int Q2_KOFF = 0, Q2_VOFF = 4 * A2_KSLOT, Q2_LUT = Q2_VOFF + 4 * A2_VSLOT, Q2_END = Q2_LUT + 1024;
template <int VAR> __device__ __forceinline__ void attn_unit_q(const P& p, int layer, int b, int h, int qb, LAS unsigned char* lds, int wave) {
    static_assert(VAR == 0 || VAR == 2, "single-map variants");
    constexpr int ND0 = (VAR == 0) ? 6 : 4, NQK = 2 * ND0;
    constexpr bool TUPLE = true;
    constexpr bool NEGM = false;
    const int tid = phase_tid(wave), lane = tid & 63, r32 = lane & 31, hi = lane >> 5, wid = wave;
    const int q0 = qb * 256, NT = 4 * (qb + 1);
    const int qidx = q0 + wid * 32 + r32, qrow = b * S + qidx;
    const unsigned char* ws = p.ws; asm volatile("" : "+s"(ws));
    const unsigned lds0 = (unsigned)(uintptr_t)lds;
    const char* ksrc; const char* ksrc2 = nullptr; const char* vsrc;
    if (VAR == 0) { ksrc = (const char*)(ws + WS_KN) + ((size_t)(b * 8 + h) * NT64 * 8 + wid) * 1024 + lane * 16;
                    ksrc2 = (const char*)(ws + WS_KR) + ((size_t)b * NT64 * 4 + (wid & 3)) * 1024 + lane * 16;
                    vsrc = (const char*)(ws + WS_VA) + (size_t)(b * 8 + h) * NT64 * 8192 + wid * 1024 + lane * 16; }
    else { ksrc = (const char*)(ws + WS_KB) + ((size_t)b * NT64 * 8 + wid) * 1024 + lane * 16;
           vsrc = (const char*)(ws + WS_VB) + (size_t)b * NT64 * 8192 + wid * 1024 + lane * 16; }
    const unsigned kdst = lds0 + Q2_KOFF + wid * 1024, kdst2 = lds0 + Q2_KOFF + (8 + (wid & 3)) * 1024, vdst = lds0 + Q2_VOFF + wid * 1024;
    const bool k2 = (VAR == 0) && (wid < 4);
    const int nkd = k2 ? 2 : 1;
#define DMA_K(t, slot) do { glds16(ksrc + (size_t)(t) * 8192, (unsigned)__builtin_amdgcn_readfirstlane(kdst + (slot) * A2_KSLOT)); \
        if (k2) glds16(ksrc2 + (size_t)(t) * 4096, (unsigned)__builtin_amdgcn_readfirstlane(kdst2 + (slot) * A2_KSLOT)); } while (0)
#define DMA_V(t, slot) glds16(vsrc + (size_t)(t) * 8192, (unsigned)__builtin_amdgcn_readfirstlane(vdst + (slot) * A2_VSLOT))
    DMA_K(0, 2); DMA_K(1, 3); DMA_V(0, 0); DMA_V(1, 1); DMA_K(2, 0); DMA_K(3, 1);
    bf16x8 qf[ND0];
    {
        const bf16_t* qp = (VAR == 0) ? (const bf16_t*)(ws + WS_QA) + (size_t)qrow * NQ_UP + h * 96 + 8 * hi : (const bf16_t*)(ws + WS_QB) + (size_t)qrow * 256 + h * 64 + 8 * hi;
#pragma unroll
        for (int i = 0; i < ND0; ++i) qf[i] = *(const GAS bf16x8*)(qp + 16 * i);
    }
    LAS float* lutl = (LAS float*)(lds + Q2_LUT);
    float bfar = 0.f;
    if (VAR == 2) {
        if (tid < 252) { int ri = tid - 64; ri = ri < 0 ? 0 : (ri > 128 ? 128 : ri); lutl[tid] = ((const float*)(ws + WS_MISC))[ri * 8 + h]; }
        bfar = ((const float*)(ws + WS_MISC))[128 * 8 + h];
    }
    const unsigned* bmrow = (const unsigned*)(ws + WS_BM) + (size_t)qrow * 128;
    const lds_cptr vp0 = (lds_cptr)lds + Q2_VOFF + ((lane >> 4) & 1) * 32 + (lane & 3) * 8 + (4 * hi + ((lane & 15) >> 2)) * 64;
    const lds_cptr kp0 = (lds_cptr)lds + Q2_KOFF + hi * 1024 + r32 * 16;
    float mhat = 0.f, l_reg = 0.f, fresc = 1.f; bool resc = false;
    f32x16 oT[2]; oT[0] = f32x16{}; oT[1] = f32x16{};
    f32x16 negm;
    f32x16 pA0, pA1, pB0, pB1; bf16x8 kf[NQK]; s16x4 vlo[8], vhi[8]; u32x4 pw0, pw1, pw2, pw3;
#define KLOAD(slot, d0) do { kf[2 * (d0)] = *(const LAS bf16x8*)(kp0 + (slot) * A2_KSLOT + (d0) * 2048); kf[2 * (d0) + 1] = *(const LAS bf16x8*)(kp0 + (slot) * A2_KSLOT + (d0) * 2048 + 512); } while (0)
#define FILLNEG() do { if (NEGM) { const float nv_ = bfar - mhat; _Pragma("unroll") for (int r = 0; r < 16; ++r) negm[r] = nv_; PIN(negm); } } while (0)
#define NEARFILL(C0, C1, t) do { \
        int bb_ = qidx - 64 * (t) - 4 * hi; bb_ = bb_ > 187 ? 187 : (bb_ < -5 ? -5 : bb_); const LAS float* lp_ = lutl + (bb_ + 5); \
        _Pragma("unroll") for (int r = 0; r < 16; ++r) { const int off_ = 8 * (r >> 2) + (r & 3); C0[r] = lp_[59 - off_] - mhat; C1[r] = lp_[27 - off_] - mhat; } \
        PIN(C0); PIN(C1); } while (0)
#define FIXUP(C0, C1, t, MASK, BW) do { \
        if (VAR == 2) { \
            const u32x2 bw_ = (BW); \
            _Pragma("unroll") for (int r = 0; r < 16; ++r) { const int sh = crow(r, hi); if (!((bw_.x >> sh) & 1u)) C0[r] = NEG_INF; if (!((bw_.y >> sh) & 1u)) C1[r] = NEG_INF; if ((r & 3) == 3) { PIN(C0); PIN(C1); SBAR(); } } \
        } else if (MASK) { \
            _Pragma("unroll") for (int r = 0; r < 16; ++r) { const int kv = 64 * (t) + crow(r, hi); if (kv > qidx) C0[r] = NEG_INF; if (kv + 32 > qidx) C1[r] = NEG_INF; } } \
    } while (0)
    u32x2 bmw = {0u, 0u}, bmw1 = {0u, 0u};
    if (VAR == 2) { bmw = *(const GAS u32x2*)(bmrow); bmw1 = *(const GAS u32x2*)(bmrow + 2); }
    wait_bar_n(0);
#pragma unroll
    for (int d0 = 0; d0 < ND0; ++d0) KLOAD(2, d0);
    {
        mhat = 0.f;
        f32x16 z = f32x16{};
        pA0 = z; pA1 = z;
        const bool near0 = (VAR == 2) && (((q0 + wid * 32) - 63) < 113);
        if (near0) NEARFILL(pA0, pA1, 0);
        const float b0 = (VAR == 2 && !near0) ? bfar : 0.f;
#pragma unroll
        for (int d0 = 0; d0 < ND0; ++d0) { pA0 = MFMA32(kf[2 * d0], qf[d0], pA0); pA1 = MFMA32(kf[2 * d0 + 1], qf[d0], pA1); }
        FIXUP(pA0, pA1, 0, (NT == 4), bmw);
        const float rm = rowmax32f(pA0, pA1) + b0;
        mhat = (VAR == 2) ? __builtin_fmaxf(rm, -40.f) : rm;
        { const float nm0 = b0 - mhat;
#pragma unroll
        for (int r = 0; r < 16; ++r) { pA0[r] = __builtin_amdgcn_exp2f(pA0[r] + nm0); pA1[r] = __builtin_amdgcn_exp2f(pA1[r] + nm0); } }
        FILLNEG();
        if (VAR == 0) { const float cv_ = bfar - mhat; _Pragma("unroll") for (int r = 0; r < 16; ++r) { pB0[r] = cv_; pB1[r] = cv_; } }
    }
    if (NT > 1) {
#pragma unroll
        for (int d0 = 0; d0 < ND0; ++d0) KLOAD(3, d0);
    }
    wait_bar_n(0);
    if (VAR == 2) bmw = bmw1;

#define PKW(P, i) cvtpk(P[i], P[i + 1])
#define PAF(k) __builtin_bit_cast(bf16x8, pw##k)
#define VFR(i) (bf16x8){vlo[i][0], vlo[i][1], vlo[i][2], vlo[i][3], vhi[i][0], vhi[i][1], vhi[i][2], vhi[i][3]}
#define VRD(i) do { vlo[i] = vtr(vp_ + (((i) >> 2) * 4096 + ((i) & 3) * 1024)); vhi[i] = vtr(vp_ + (((i) >> 2) * 4096 + ((i) & 3) * 1024 + 512)); } while (0)
#define EX4N(X, i, nm) do { X[i] = __builtin_amdgcn_exp2f(X[i] + (nm)); X[i + 1] = __builtin_amdgcn_exp2f(X[i + 1] + (nm)); X[i + 2] = __builtin_amdgcn_exp2f(X[i + 2] + (nm)); X[i + 3] = __builtin_amdgcn_exp2f(X[i + 3] + (nm)); PIN(X); } while (0)
#define EX4(X, i) do { X[i] = __builtin_amdgcn_exp2f(X[i]); X[i + 1] = __builtin_amdgcn_exp2f(X[i + 1]); X[i + 2] = __builtin_amdgcn_exp2f(X[i + 2]); X[i + 3] = __builtin_amdgcn_exp2f(X[i + 3]); PIN(X); } while (0)
#define GAPA(C0, C1, P0, P1, g) do { \
        if ((g) < 8) { VRD(((g) >> 1) + 4 * ((g) & 1)); SBAR(); }                                    \
        if ((g) >= 2 || near_ || !NEGM) { if (((g) & 1) == 0) C0 = MFMA32(kf[g], qf[(g) >> 1], C0); else C1 = MFMA32(kf[g], qf[(g) >> 1], C1); } \
        else { if (((g) & 1) == 0) C0 = MFMA32(kf[g], qf[(g) >> 1], negm); else C1 = MFMA32(kf[g], qf[(g) >> 1], negm); } \
        if ((g) < 8) { const int a_ = 4 * (g); \
            if (a_ < 16) { sacc += P0[a_]; sacc += P0[a_ + 1]; sacc += P0[a_ + 2]; sacc += P0[a_ + 3]; } else { sacc += P1[a_ - 16]; sacc += P1[a_ - 15]; sacc += P1[a_ - 14]; sacc += P1[a_ - 13]; } \
            if ((g) == 0) { pw0[0] = PKW(P0, 0); pw0[1] = PKW(P0, 2); PIN(pw0); } if ((g) == 1) { pw0[2] = PKW(P0, 4); pw0[3] = PKW(P0, 6); PIN(pw0); } \
            if ((g) == 2) { pw1[0] = PKW(P0, 8); pw1[1] = PKW(P0, 10); PIN(pw1); } if ((g) == 3) { pw1[2] = PKW(P0, 12); pw1[3] = PKW(P0, 14); PIN(pw1); } \
            if ((g) == 4) { pw2[0] = PKW(P1, 0); pw2[1] = PKW(P1, 2); PIN(pw2); } if ((g) == 5) { pw2[2] = PKW(P1, 4); pw2[3] = PKW(P1, 6); PIN(pw2); } \
            if ((g) == 6) { pw3[0] = PKW(P1, 8); pw3[1] = PKW(P1, 10); PIN(pw3); } if ((g) == 7) { pw3[2] = PKW(P1, 12); pw3[3] = PKW(P1, 14); PIN(pw3); } \
            PIN(sacc); } \
        if (VAR == 0 && (g) >= 8) { const float cvn_ = bfar - mhat; const int e_ = 4 * ((g) - 8);                                       \
            P0[e_] = cvn_; P0[e_ + 1] = cvn_; P0[e_ + 2] = cvn_; P0[e_ + 3] = cvn_; P1[e_] = cvn_; P1[e_ + 1] = cvn_; P1[e_ + 2] = cvn_; P1[e_ + 3] = cvn_; PIN(P0); PIN(P1); } \
        SBAR(); } while (0)
#define STEP(C0, C1, P0, P1, t, MASK, GL, VSL, KSL) do { SBAR(); \
        const lds_cptr vp_ = vp0 + (VSL) * A2_VSLOT; float sacc = 0.f; \
        const bool near_ = (VAR == 2) && (((q0 + wid * 32) - (64 * (t) + 63)) < 113); \
        if (near_) NEARFILL(C0, C1, t); \
        else if (VAR == 2) {                                       \
            const unsigned cvb_ = __float_as_uint(bfar - mhat), wx_ = bmw.x >> (4 * hi), wy_ = bmw.y >> (4 * hi); \
            _Pragma("unroll") for (int r = 0; r < 16; ++r) { const int cb_ = (r & 3) + 8 * (r >> 2); \
                const unsigned m0_ = (unsigned)__builtin_amdgcn_sbfe((int)wx_, cb_, 1), m1_ = (unsigned)__builtin_amdgcn_sbfe((int)wy_, cb_, 1); \
                C0[r] = __uint_as_float((m0_ & cvb_) | (~m0_ & 0xff800000u)); C1[r] = __uint_as_float((m1_ & cvb_) | (~m1_ & 0xff800000u)); } \
            PIN(C0); PIN(C1); } \
        else if (!NEGM && VAR != 0) { const float cv_ = bfar - mhat; _Pragma("unroll") for (int r = 0; r < 16; ++r) { C0[r] = cv_; C1[r] = cv_; } PIN(C0); PIN(C1); } \
        u32x2 bwn_ = {0u, 0u}; if (VAR == 2 && (t) + 1 < NT) bwn_ = *(const GAS u32x2*)(bmrow + 2 * ((t) + 1));     \
        _Pragma("unroll") for (int g_ = 0; g_ < NQK; ++g_) GAPA(C0, C1, P0, P1, g_); \
        l_reg += sacc; \
        if (VAR != 2 || near_) FIXUP(C0, C1, t, MASK, bmw); \
        bmw = bwn_; \
        float nm_ = TUPLE ? 0.f : ((near_ ? 0.f : bfar) - mhat);                                    \
        { const float rm = rowmax32f(C0, C1) + nm_; resc = false;                                    \
          if (__builtin_expect(__any(rm > A2_THR), 0)) { const float dl = __builtin_fmaxf(rm, 0.f); mhat += dl; fresc = __builtin_amdgcn_exp2f(-dl); l_reg *= fresc; resc = true; \
              if (TUPLE) { _Pragma("unroll") for (int r = 0; r < 16; ++r) { C0[r] -= dl; C1[r] -= dl; } FILLNEG(); } else nm_ -= dl; \
              if (VAR == 0) { const float cvn_ = bfar - mhat; _Pragma("unroll") for (int r = 0; r < 16; ++r) { P0[r] = cvn_; P1[r] = cvn_; } PIN(P0); PIN(P1); } } } \
        SBAR(); \
        _Pragma("unroll") for (int i_ = 0; i_ < 8; ++i_) { \
            if (GL && i_ >= 1 && i_ - 1 < ND0) { KLOAD(KSL, i_ - 1); SBAR(); } \
            { const int ks_ = i_ >> 1, db_ = i_ & 1, vi_ = 4 * db_ + ks_; \
              const bf16x8 pa_ = (ks_ == 0) ? PAF(0) : (ks_ == 1) ? PAF(1) : (ks_ == 2) ? PAF(2) : PAF(3); \
              oT[db_] = MFMA32(VFR(vi_), pa_, oT[db_]); } \
            if (TUPLE) { if (i_ < 4) EX4(C0, 4 * i_); else EX4(C1, 4 * (i_ - 4)); } else { if (i_ < 4) EX4N(C0, 4 * i_, nm_); else EX4N(C1, 4 * (i_ - 4), nm_); } \
            SBAR(); } \
    } while (0)
#define RESC() do { if (resc) { _Pragma("unroll") for (int r = 0; r < 16; ++r) { oT[0][r] *= fresc; oT[1][r] *= fresc; } } } while (0)
    for (int T2 = 0; 2 * T2 + 1 < NT; ++T2) {
        const int ta = 2 * T2 + 1, pcur = T2 & 1, pnxt = pcur ^ 1;
        if (ta + 3 < NT) DMA_K(ta + 3, 2 * pnxt);
        if (ta + 4 < NT) DMA_K(ta + 4, 2 * pnxt + 1);
        if (ta + 1 < NT) DMA_V(ta + 1, 2 * pnxt);
        if (ta + 2 < NT) DMA_V(ta + 2, 2 * pnxt + 1);
        STEP(pB0, pB1, pA0, pA1, ta, (ta >= NT - 4), (ta + 1 < NT), 2 * pcur, 2 * pcur); RESC();
        if (ta + 1 < NT) { STEP(pA0, pA1, pB0, pB1, ta + 1, (ta + 1 >= NT - 4), (ta + 2 < NT), 2 * pcur + 1, 2 * pcur + 1); RESC(); }
        wait_bar_n(0);
    }
    const int sl_cur = 2 * (((NT - 2) >> 1) & 1) + 1;
    { float sacc = 0.f;
#pragma unroll
      for (int r = 0; r < 16; ++r) sacc += pB0[r] + pB1[r];
      l_reg += sacc;
      pw0 = (u32x4){PKW(pB0, 0), PKW(pB0, 2), PKW(pB0, 4), PKW(pB0, 6)}; pw1 = (u32x4){PKW(pB0, 8), PKW(pB0, 10), PKW(pB0, 12), PKW(pB0, 14)};
      pw2 = (u32x4){PKW(pB1, 0), PKW(pB1, 2), PKW(pB1, 4), PKW(pB1, 6)}; pw3 = (u32x4){PKW(pB1, 8), PKW(pB1, 10), PKW(pB1, 12), PKW(pB1, 14)};
      const lds_cptr vp_ = vp0 + sl_cur * A2_VSLOT;
#pragma unroll
      for (int i = 0; i < 8; ++i) VRD(i);
#pragma unroll
      for (int ks = 0; ks < 4; ++ks) { const bf16x8 pa_ = (ks == 0) ? PAF(0) : (ks == 1) ? PAF(1) : (ks == 2) ? PAF(2) : PAF(3);
          oT[0] = MFMA32(VFR(ks), pa_, oT[0]); oT[1] = MFMA32(VFR(4 + ks), pa_, oT[1]); } }
    const float il = 1.0f / xhalf_sum(l_reg);
    bf16_t* mix = (bf16_t*)(ws + WS_MIX) + (size_t)qrow * DM + (VAR == 0 ? h * 64 : 512 + h * 64) + 4 * hi;
#pragma unroll
    for (int db = 0; db < 2; ++db)
#pragma unroll
        for (int g = 0; g < 4; ++g) { u32x2 w; w.x = pk2(oT[db][4 * g] * il, oT[db][4 * g + 1] * il); w.y = pk2(oT[db][4 * g + 2] * il, oT[db][4 * g + 3] * il); *(GAS u32x2*)(mix + 32 * db + 8 * g) = w; }
    wait_bar_n(0);
#undef DMA_K
#undef DMA_V
#undef KLOAD
#undef FILLNEG
#undef FIXUP
#undef NEARFILL
#undef PKW
#undef PAF
#undef VFR
#undef VRD
#undef EX4
#undef EX4N
#undef GAPA
#undef STEP
#undef RESC
}
__device__ __forceinline__ void attn_unit_pd(const P& p, int layer, int b, int h, int qb, LAS unsigned char* lds, int wave) {
    const int tid = phase_tid(wave), lane = tid & 63, r32 = lane & 31, hi = lane >> 5, wid = wave;
    const int q0 = qb * 256, NT = 4 * (qb + 1);
    const int qidx = q0 + wid * 32 + r32, qrow = b * S + qidx;
    const unsigned char* ws = p.ws; asm volatile("" : "+s"(ws));
    const unsigned lds0 = (unsigned)(uintptr_t)lds;
    const char* ksrc = (const char*)(ws + WS_KC) + ((size_t)(b * 4 + h) * NT64 * 8 + wid) * 1024 + lane * 16;
    const char* vsrc = (const char*)(ws + WS_VC) + (size_t)(b * 4 + h) * NT64 * 8192 + wid * 1024 + lane * 16;
    const unsigned kdst = lds0 + A2_KOFF + wid * 1024, vdst = lds0 + A2_VOFF + wid * 1024;
#define DMA_K(t, slot) glds16(ksrc + (size_t)(t) * 8192, (unsigned)__builtin_amdgcn_readfirstlane(kdst + (slot) * A2_KSLOT))
#define DMA_V(t, slot) glds16(vsrc + (size_t)(t) * 8192, (unsigned)__builtin_amdgcn_readfirstlane(vdst + (slot) * A2_VSLOT))
    DMA_K(0, 0); DMA_V(0, 0); DMA_K(1, 1);
    bf16x8 qf[4];
    { const bf16_t* qp = (const bf16_t*)(ws + WS_QC) + (size_t)qrow * 256 + h * 64 + 8 * hi;
#pragma unroll
      for (int i = 0; i < 4; ++i) qf[i] = *(const GAS bf16x8*)(qp + 16 * i); }
    LAS float* lutl = (LAS float*)(lds + A2_LUT);
    if (tid < 252) { int ri = tid - 64; ri = ri < 0 ? 0 : (ri > 128 ? 128 : ri); lutl[tid] = ((const float*)(ws + WS_MISC))[ri * 8 + 4 + h] - ((const float*)(ws + WS_MISC))[128 * 8 + 4 + h]; }
    const lds_cptr vp0 = (lds_cptr)lds + A2_VOFF + ((lane >> 4) & 1) * 32 + (lane & 3) * 8 + (4 * hi + ((lane & 15) >> 2)) * 64;
    const lds_cptr kp0 = (lds_cptr)lds + A2_KOFF + hi * 1024 + r32 * 16;
    float mhat0 = 0.f, mhat1 = 0.f, l0 = 0.f, l1 = 0.f;
    bool zr0 = true, zr1 = true;
    f32x16 oA[2], oB[2]; oA[0] = f32x16{}; oA[1] = f32x16{}; oB[0] = f32x16{}; oB[1] = f32x16{};
    f32x16 sc0, sc1; bf16x8 kfa[4], kfb[4]; s16x4 vlo[2], vhi[2];
    u32x4 pw0 = {0u, 0u, 0u, 0u}, pw1 = pw0, pw2 = pw0, pw3 = pw0;
    int sl_prev = 0, sl_cur = 0, sl_next = 1;
#define ROT() do { sl_prev = sl_cur; sl_cur = sl_next; sl_next = (sl_next == 2) ? 0 : sl_next + 1; } while (0)
#define KLD(KF, slot, c, d0) do { KF[2 * (d0)] = *(const LAS bf16x8*)(kp0 + (slot) * A2_KSLOT + (c) * 4096 + (d0) * 2048); KF[2 * (d0) + 1] = *(const LAS bf16x8*)(kp0 + (slot) * A2_KSLOT + (c) * 4096 + (d0) * 2048 + 512); } while (0)
#define CFILL(C0, C1, t, MH, NR) do { \
        if (NR) { \
            int bb_ = qidx - 64 * (t) - 4 * hi; bb_ = bb_ > 187 ? 187 : (bb_ < -5 ? -5 : bb_); const LAS float* lp_ = lutl + (bb_ + 5); const float mh_ = (MH); \
            _Pragma("unroll") for (int r = 0; r < 16; ++r) { const int off_ = 8 * (r >> 2) + (r & 3); C0[r] = lp_[59 - off_] - mh_; C1[r] = lp_[27 - off_] - mh_; if ((r & 3) == 3) { PIN(C0); PIN(C1); } } \
        } else { const float cv_ = -(MH); _Pragma("unroll") for (int r = 0; r < 16; ++r) { C0[r] = cv_; C1[r] = cv_; } PIN(C0); PIN(C1); } } while (0)
#define CMASK(C0, C1, t) do { int qd_ = qidx - 64 * (t) - 4 * hi; asm volatile("" : "+v"(qd_));     \
        _Pragma("unroll") for (int r = 0; r < 16; ++r) { const int kv = (r & 3) + 8 * (r >> 2); if (kv > qd_) C0[r] = NEG_INF; if (kv + 32 > qd_) C1[r] = NEG_INF; } } while (0)
#define PKW(P, i) cvtpk(P[i], P[i + 1])
#define PAF(k) __builtin_bit_cast(bf16x8, pw##k)
#define VFR(i) (bf16x8){vlo[i][0], vlo[i][1], vlo[i][2], vlo[i][3], vhi[i][0], vhi[i][1], vhi[i][2], vhi[i][3]}
#define VRDJ(j, i) do { vlo[j] = vtr(vp_ + (((i) >> 2) * 4096 + ((i) & 3) * 1024)); vhi[j] = vtr(vp_ + (((i) >> 2) * 4096 + ((i) & 3) * 1024 + 512)); } while (0)
#define EXS4(X, i) do { X[i] = __builtin_amdgcn_exp2f(X[i]); X[i + 1] = __builtin_amdgcn_exp2f(X[i + 1]); X[i + 2] = __builtin_amdgcn_exp2f(X[i + 2]); X[i + 3] = __builtin_amdgcn_exp2f(X[i + 3]); \
        sacc += X[i]; sacc += X[i + 1]; sacc += X[i + 2]; sacc += X[i + 3]; PIN(X); PIN(sacc); } while (0)
#define STEPD(KF, QB, t, MASK, MH, ZR, LC, OC, OP, VS, KFN, KS, KC, GL) do { SBAR(); \
        const lds_cptr vp_ = vp0 + (VS) * A2_VSLOT; float sacc = 0.f; \
        const bool nr_ = ((q0 + wid * 32) - (64 * (t) + 63)) < 113; \
        if (!nr_ && ZR) { sc0 = MFMA32(KF[0], qf[(QB)], f32x16{}); sc1 = MFMA32(KF[1], qf[(QB)], f32x16{}); }        \
        else { asm volatile(""); CFILL(sc0, sc1, t, MH, nr_); sc0 = MFMA32(KF[0], qf[(QB)], sc0); sc1 = MFMA32(KF[1], qf[(QB)], sc1); } \
        sc0 = MFMA32(KF[2], qf[(QB) + 1], sc0); sc1 = MFMA32(KF[3], qf[(QB) + 1], sc1); \
        VRDJ(0, 0); SBAR(); \
        if (MASK) CMASK(sc0, sc1, t); \
        { const float rm = rowmax32f(sc0, sc1); \
          if (__builtin_expect(__any(rm > A2_THR), 0)) { const float dl = __builtin_fmaxf(rm, 0.f); MH += dl; ZR = false; const float f_ = __builtin_amdgcn_exp2f(-dl); LC *= f_; \
              _Pragma("unroll") for (int r = 0; r < 16; ++r) { sc0[r] -= dl; sc1[r] -= dl; OC[0][r] *= f_; OC[1][r] *= f_; } } } \
        SBAR(); \
        _Pragma("unroll") for (int i_ = 0; i_ < 8; ++i_) { \
            if (i_ < 7) { VRDJ((i_ + 1) & 1, 4 * ((i_ + 1) & 1) + ((i_ + 1) >> 1)); }                   \
            if (GL && (i_ == 2 || i_ == 4)) { KLD(KFN, KS, KC, (i_ >> 1) - 1); } \
            SBAR(); \
            { const int ks_ = i_ >> 1, db_ = i_ & 1; \
              const bf16x8 pa_ = (ks_ == 0) ? PAF(0) : (ks_ == 1) ? PAF(1) : (ks_ == 2) ? PAF(2) : PAF(3); \
              OP[db_] = MFMA32(VFR(i_ & 1), pa_, OP[db_]); } \
            if (i_ < 4) EXS4(sc0, 4 * i_); else EXS4(sc1, 4 * (i_ - 4)); \
            if (i_ == 1) { pw0 = (u32x4){PKW(sc0, 0), PKW(sc0, 2), PKW(sc0, 4), PKW(sc0, 6)}; PIN(pw0); } \
            if (i_ == 3) { pw1 = (u32x4){PKW(sc0, 8), PKW(sc0, 10), PKW(sc0, 12), PKW(sc0, 14)}; PIN(pw1); } \
            if (i_ == 5) { pw2 = (u32x4){PKW(sc1, 0), PKW(sc1, 2), PKW(sc1, 4), PKW(sc1, 6)}; PIN(pw2); } \
            if (i_ == 7) { pw3 = (u32x4){PKW(sc1, 8), PKW(sc1, 10), PKW(sc1, 12), PKW(sc1, 14)}; PIN(pw3); } \
            SBAR(); } \
        LC += sacc; \
    } while (0)
    wait_bar_n(0);
    KLD(kfa, 0, 0, 0); KLD(kfa, 0, 0, 1);
    sl_prev = 2;
    for (int t = 0; t < NT; ++t) {
        if (t + 2 < NT) DMA_K(t + 2, sl_prev);
        if (t + 1 < NT) DMA_V(t + 1, sl_next);
        const bool mask_ = (t >= NT - 4);
        const int vs0_ = (t == 0) ? sl_cur : sl_prev;
        STEPD(kfa, 0, t, mask_, mhat0, zr0, l0, oA, oB, vs0_, kfb, sl_cur, 1, true);
        STEPD(kfb, 2, t, mask_, mhat1, zr1, l1, oB, oA, sl_cur, kfa, sl_next, 0, (t + 1 < NT));
        wait_bar_n(0); ROT();
    }
    { const lds_cptr vp_ = vp0 + sl_prev * A2_VSLOT;
#pragma unroll
      for (int ks = 0; ks < 4; ++ks) { const bf16x8 pa_ = (ks == 0) ? PAF(0) : (ks == 1) ? PAF(1) : (ks == 2) ? PAF(2) : PAF(3);
          VRDJ(0, ks); VRDJ(1, 4 + ks); oB[0] = MFMA32(VFR(0), pa_, oB[0]); oB[1] = MFMA32(VFR(1), pa_, oB[1]); SBAR(); } }
    {
        const float* lp = p.diff_lambda + layer * 128; float d01 = 0.f, d23 = 0.f;
        for (int i = 0; i < 32; ++i) { d01 += lp[i] * lp[32 + i]; d23 += lp[64 + i] * lp[96 + i]; }
        const float lam_init = lam_init_of(layer), lam = expf(d01) - expf(d23) + lam_init;
        const float i0 = 1.0f / xhalf_sum(l0), i1 = lam / xhalf_sum(l1);
        float ss = 0.f;
#pragma unroll
        for (int db = 0; db < 2; ++db)
#pragma unroll
            for (int r = 0; r < 16; ++r) { const float v = oA[db][r] * i0 - oB[db][r] * i1; oA[db][r] = v; ss += v * v; }
        ss = xhalf_sum(ss);
        const float rsn = 1.0f / sqrtf(ss / 64.f + EPS) * (1.f - lam_init);
        const float* g = p.diff_subln + layer * 64;
        bf16_t* mix = (bf16_t*)(ws + WS_MIX) + (size_t)qrow * DM + 768 + h * 64 + 4 * hi;
#pragma unroll
        for (int db = 0; db < 2; ++db)
#pragma unroll
            for (int gg = 0; gg < 4; ++gg) { float o4[4];
#pragma unroll
                for (int i = 0; i < 4; ++i) o4[i] = oA[db][4 * gg + i] * rsn * g[32 * db + 8 * gg + 4 * hi + i];
                u32x2 w; w.x = pk2(o4[0], o4[1]); w.y = pk2(o4[2], o4[3]); *(GAS u32x2*)(mix + 32 * db + 8 * gg) = w; }
    }
    wait_bar_n(0);
#undef DMA_K
#undef DMA_V
#undef ROT
#undef KLD
#undef CFILL
#undef CMASK
#undef PKW
#undef PAF
#undef VFR
#undef EXS4
#undef VRDJ
#undef STEPD
}
constexpr int SEL_KPITCH = 4104;
constexpr int SEL_HSTRIDE = 260;
constexpr int SEL_HIST = 16 * SEL_KPITCH * 2;
__device__ __forceinline__ unsigned score_key(float s) {
    const _Float16 hf = (_Float16)s; unsigned u = (unsigned)__builtin_bit_cast(unsigned short, hf);
    if (u == 0x8000u) u = 0u;
    return (u & 0x8000u) ? (~u & 0xffffu) : (u | 0x8000u);
}
__device__ __forceinline__ unsigned wave_scan_incl(unsigned v) {
#define DPP_ADD(ctrl, rm) v += (unsigned)__builtin_amdgcn_update_dpp(0, (int)v, ctrl, rm, 0xf, false)
    DPP_ADD(0x111, 0xf); DPP_ADD(0x112, 0xf); DPP_ADD(0x114, 0xf); DPP_ADD(0x118, 0xf); DPP_ADD(0x142, 0xa); DPP_ADD(0x143, 0xc);
#undef DPP_ADD
    return v;
}
__device__ __forceinline__ void find_bin2(LAS unsigned* hist, int lane, unsigned tgtA, unsigned tgtB, unsigned& binA, unsigned& aboveA, unsigned& binB, unsigned& aboveB) {
    const u32x4 c = *(LAS u32x4*)(hist + 4 * lane);
    const unsigned inc = wave_scan_incl(c.x + c.y + c.z + c.w);
    const unsigned all = (unsigned)__builtin_amdgcn_readlane((int)inc, 63);
    unsigned ab = all - inc;
    unsigned abA = ab & 0xffffu, abB = ab >> 16;
    unsigned fA = 0u, fbA = 0u, faA = 0u, fB = 0u, fbB = 0u, faB = 0u;
    const unsigned cc[4] = {c.x, c.y, c.z, c.w};
#pragma unroll
    for (int i = 3; i >= 0; --i) { const unsigned a = cc[i] & 0xffffu, bq = cc[i] >> 16;
        if (!fA && abA + a >= tgtA) { fA = 1u; fbA = 4 * lane + i; faA = abA; } abA += a;
        if (!fB && abB + bq >= tgtB) { fB = 1u; fbB = 4 * lane + i; faB = abB; } abB += bq; }
    const unsigned long long balA = __ballot(fA != 0u), balB = __ballot(fB != 0u);
    const int srcA = __builtin_amdgcn_readfirstlane(63 - __builtin_clzll(balA | 1ull)), srcB = __builtin_amdgcn_readfirstlane(63 - __builtin_clzll(balB | 1ull));
    binA = (unsigned)__builtin_amdgcn_readlane((int)fbA, srcA); aboveA = (unsigned)__builtin_amdgcn_readlane((int)faA, srcA);
    binB = (unsigned)__builtin_amdgcn_readlane((int)fbB, srcB); aboveB = (unsigned)__builtin_amdgcn_readlane((int)faB, srcB);
}
typedef unsigned short u16x2 __attribute__((ext_vector_type(2)));
__device__ __forceinline__ unsigned fold8(unsigned a, unsigned b_, unsigned c, unsigned d) {
    const unsigned x = a + (b_ << 2) + (c << 4) + (d << 6); return (x & 0x55u) | ((x >> 15) & 0xaau); }
__device__ __forceinline__ void group_masks(LAS const unsigned short* kq, int lane, unsigned thr, unsigned long long& gtm, unsigned long long& eqm) {
    gtm = 0ull; eqm = 0ull;
    const unsigned t2 = thr | (thr << 16); const u16x2 tv = __builtin_bit_cast(u16x2, t2), one = {1, 1};
#pragma unroll
    for (int i = 0; i < 8; ++i) { const int ch = (i + lane) & 7;
        const u32x4 v = *(LAS const u32x4*)(kq + 8 * ch);
        unsigned g[4], n[4]; const unsigned w[4] = {v.x, v.y, v.z, v.w};
#pragma unroll
        for (int u = 0; u < 4; ++u) { const u16x2 k = __builtin_bit_cast(u16x2, w[u]);
            g[u] = __builtin_bit_cast(unsigned, __builtin_elementwise_min(__builtin_elementwise_sub_sat(k, tv), one));
            n[u] = __builtin_bit_cast(unsigned, __builtin_elementwise_min(__builtin_bit_cast(u16x2, w[u] ^ t2), one)); }
        const unsigned g8 = fold8(g[0], g[1], g[2], g[3]), e8 = fold8(n[0], n[1], n[2], n[3]) ^ 0xffu;
        gtm |= (unsigned long long)g8 << (8 * ch); eqm |= (unsigned long long)e8 << (8 * ch); }
}
__device__ __forceinline__ void select_unit(const P& p, int b, int qblk, LAS unsigned char* lds, int wave_id) {
    const int tid = phase_tid(wave_id), lane = tid & 63, wave = wave_id;
    const int q0 = qblk * 16, row0 = b * S + q0, nk = q0 + 16;
    LAS unsigned short* keys = (LAS unsigned short*)lds;
    LAS unsigned* hist0 = (LAS unsigned*)(lds + SEL_HIST);
    LAS unsigned* hist = hist0 + wave * SEL_HSTRIDE;
    const unsigned char* ws = p.ws; asm volatile("" : "+s"(ws));
    unsigned z0 = 0u; asm volatile("" : "+v"(z0));
#ifndef PROBE
#define PROBE 0
#endif
    for (int rep_ = 0; rep_ < (PROBE == 11 ? 2 : 1); ++rep_) {
    *(LAS u32x4*)(hist + 4 * lane) = (u32x4){z0, z0, z0, z0};
    __syncthreads();
    {
        const int qc = lane & 15, kg = lane >> 4;
        const bf16_t* QI = (const bf16_t*)(ws + WS_QI) + (size_t)(row0 + qc) * 256 + 8 * kg;
        bf16x8 qf[8];
#pragma unroll
        for (int h = 0; h < 8; ++h) qf[h] = *(const GAS bf16x8*)(QI + h * 32);
        const float* WI = (const float*)(ws + WS_WI) + (size_t)(row0 + qc) * 8;
        const f32x4 w0 = *(const GAS f32x4*)WI, w1 = *(const GAS f32x4*)(WI + 4);
        const float w[8] = {0.5f * w0.x, 0.5f * w0.y, 0.5f * w0.z, 0.5f * w0.w, 0.5f * w1.x, 0.5f * w1.y, 0.5f * w1.z, 0.5f * w1.w};
        bf16x8 qlh, qll;
        {
            float ql[8];
#pragma unroll
            for (int e = 0; e < 8; ++e) ql[e] = 0.f;
#pragma unroll
            for (int h = 0; h < 8; ++h) { float t8[8]; unpk8(__builtin_bit_cast(u32x4, qf[h]), t8);
#pragma unroll
                for (int e = 0; e < 8; ++e) ql[e] += w[h] * t8[e]; }
            const u32x4 hi4 = pk8(ql); float hf[8], lo[8]; unpk8(hi4, hf);
#pragma unroll
            for (int e = 0; e < 8; ++e) lo[e] = ql[e] - hf[e];
            qlh = __builtin_bit_cast(bf16x8, hi4); qll = __builtin_bit_cast(bf16x8, pk8(lo));
        }
        const bf16_t* KI = (const bf16_t*)(ws + WS_KI) + (size_t)(b * S + qc) * 32 + 8 * kg;
        LAS unsigned* hq = hist0 + (qc >> 1) * SEL_HSTRIDE; const unsigned hinc = (qc & 1) ? 0x10000u : 1u;
        const int nch = nk / 16;
        bf16x8 ka = *(const GAS bf16x8*)(KI + (size_t)(wave < nch ? wave : 0) * 512), kb = *(const GAS bf16x8*)(KI + (size_t)(wave + 8 < nch ? wave + 8 : 0) * 512);
        for (int c = wave; c < nch; c += 16) {
            const int c2 = c + 16, c3 = c + 24;
            const bf16x8 na = *(const GAS bf16x8*)(KI + (size_t)(c2 < nch ? c2 : 0) * 512), nb = *(const GAS bf16x8*)(KI + (size_t)(c3 < nch ? c3 : 0) * 512);
#pragma unroll
            for (int u = 0; u < 2; ++u) {
                const int cc = c + 8 * u; if (cc >= nch) break;
                const bf16x8 kf = u ? kb : ka;
                f32x4 sc = MFMA16(kf, qll, MFMA16(kf, qlh, ((f32x4){0.f, 0.f, 0.f, 0.f})));
                f32x4 dh[8];
#pragma unroll
                for (int h = 0; h < 8; ++h) dh[h] = MFMA16(kf, qf[h], ((f32x4){0.f, 0.f, 0.f, 0.f}));
                __builtin_amdgcn_sched_barrier(0);
#pragma unroll
                for (int h = 0; h < 8; ++h)
#pragma unroll
                    for (int i = 0; i < 4; ++i) sc[i] = __builtin_fmaf(w[h], __builtin_fabsf(dh[h][i]), sc[i]);
                const int kbase = 16 * cc + 4 * kg;
                typedef __fp16 h2 __attribute__((ext_vector_type(2)));
                const h2 p01 = __builtin_amdgcn_cvt_pkrtz(sc[0], sc[1]), p23 = __builtin_amdgcn_cvt_pkrtz(sc[2], sc[3]);
                unsigned x0 = __builtin_bit_cast(unsigned, p01), x1 = __builtin_bit_cast(unsigned, p23);
                { typedef short s16x2 __attribute__((ext_vector_type(2)));
                  const unsigned m0 = __builtin_bit_cast(unsigned, __builtin_bit_cast(s16x2, x0) >> 15), m1 = __builtin_bit_cast(unsigned, __builtin_bit_cast(s16x2, x1) >> 15);
                  x0 ^= (m0 | 0x80008000u); x1 ^= (m1 | 0x80008000u); }
                if (cc == nch - 1) {
                    asm volatile("");
                    const int lim = q0 + qc - kbase;
                    if (lim < 0) x0 = 0u; else if (lim < 1) x0 &= 0x0000ffffu;
                    if (lim < 2) x1 = 0u; else if (lim < 3) x1 &= 0x0000ffffu;
                }
                u32x2 wv; wv.x = x0; wv.y = x1;
                *(LAS u32x2*)(keys + qc * SEL_KPITCH + kbase) = wv;
                __hip_atomic_fetch_add(hq + ((x0 >> 8) & 0xffu), hinc, __ATOMIC_RELAXED, __HIP_MEMORY_SCOPE_WORKGROUP); __hip_atomic_fetch_add(hq + (x0 >> 24), hinc, __ATOMIC_RELAXED, __HIP_MEMORY_SCOPE_WORKGROUP);
                __hip_atomic_fetch_add(hq + ((x1 >> 8) & 0xffu), hinc, __ATOMIC_RELAXED, __HIP_MEMORY_SCOPE_WORKGROUP); __hip_atomic_fetch_add(hq + (x1 >> 24), hinc, __ATOMIC_RELAXED, __HIP_MEMORY_SCOPE_WORKGROUP);
            }
            ka = na; kb = nb;
        }
    }
    __syncthreads();
    }
    unsigned* BM = (unsigned*)(ws + WS_BM);
    {
        const int qa = 2 * wave, tA = q0 + qa, tB = tA + 1, nA = tA + 1, nB = tB + 1;
        LAS unsigned short* kqA = keys + qa * SEL_KPITCH; LAS unsigned short* kqB = kqA + SEL_KPITCH;
        unsigned thrA = 0u, thrB = 0u, ntA = 0u, ntB = 0u;
        if (nB > NSEL) {
            unsigned b1A, a1A, b1B, a1B; find_bin2(hist, lane, (unsigned)NSEL, (unsigned)NSEL, b1A, a1A, b1B, a1B);
            const unsigned r1A = (unsigned)NSEL - a1A, r1B = (unsigned)NSEL - a1B;
            asm volatile("s_waitcnt lgkmcnt(0)" ::: "memory");
            *(LAS u32x4*)(hist + 4 * lane) = (u32x4){z0, z0, z0, z0};
            asm volatile("s_waitcnt lgkmcnt(0)" ::: "memory");
            for (int i = 4 * lane; i < nk; i += 256) { const u32x2 kA2 = *(LAS u32x2*)(kqA + i), kB2 = *(LAS u32x2*)(kqB + i);
                const unsigned eA[4] = {kA2.x & 0xffffu, kA2.x >> 16, kA2.y & 0xffffu, kA2.y >> 16}, eB[4] = {kB2.x & 0xffffu, kB2.x >> 16, kB2.y & 0xffffu, kB2.y >> 16};
#pragma unroll
                for (int u = 0; u < 4; ++u) { if ((eA[u] >> 8) == b1A) __hip_atomic_fetch_add(hist + (eA[u] & 0xffu), 1u, __ATOMIC_RELAXED, __HIP_MEMORY_SCOPE_WORKGROUP);
                                              if ((eB[u] >> 8) == b1B) __hip_atomic_fetch_add(hist + (eB[u] & 0xffu), 0x10000u, __ATOMIC_RELAXED, __HIP_MEMORY_SCOPE_WORKGROUP); } }
            asm volatile("s_waitcnt lgkmcnt(0)" ::: "memory");
            unsigned b2A, a2A, b2B, a2B; find_bin2(hist, lane, r1A, r1B, b2A, a2A, b2B, a2B);
            thrA = (b1A << 8) | b2A; ntA = r1A - a2A; thrB = (b1B << 8) | b2B; ntB = r1B - a2B;
            asm volatile("s_waitcnt lgkmcnt(0)" ::: "memory");
        }
        const int gbase = 64 * lane;
        unsigned long long mA, mB;
        { const int cA = tA + 1 - gbase, cB = tB + 1 - gbase;
          mA = cA >= 64 ? ~0ull : (cA > 0 ? ((1ull << cA) - 1ull) : 0ull); mB = cB >= 64 ? ~0ull : (cB > 0 ? ((1ull << cB) - 1ull) : 0ull); }
        if (nB > NSEL) {
            unsigned long long gA = 0ull, eA = 0ull, gB = 0ull, eB = 0ull;
            if (gbase < nk) { group_masks(kqA + gbase, lane, thrA, gA, eA); group_masks(kqB + gbase, lane, thrB, gB, eB);
                const int vb = nk - gbase; if (vb < 64) { const unsigned long long vm = (1ull << vb) - 1ull; gA &= vm; eA &= vm; gB &= vm; eB &= vm; } }
            int cntA = __builtin_popcountll(eA), cntB = __builtin_popcountll(eB);
            const unsigned inc = wave_scan_incl((unsigned)cntA | ((unsigned)cntB << 16));
            int keepA = (int)ntA - ((int)(inc & 0xffffu) - cntA), keepB = (int)ntB - ((int)(inc >> 16) - cntB);
            keepA = keepA < 0 ? 0 : keepA; keepB = keepB < 0 ? 0 : keepB;
            while (cntA > keepA) { eA &= ~(1ull << (63 - __builtin_clzll(eA))); --cntA; }
            while (cntB > keepB) { eB &= ~(1ull << (63 - __builtin_clzll(eB))); --cntB; }
            if (nA > NSEL) mA = gA | eA;
            mB = gB | eB;
        }
        *(GAS unsigned long long*)(BM + (size_t)(row0 + qa) * 128 + 2 * lane) = mA;
        *(GAS unsigned long long*)(BM + (size_t)(row0 + qa + 1) * 128 + 2 * lane) = mB;
    }
    __syncthreads();
}
#ifdef NO_DIFF_P
#define U_DIFF_P(x)
#else
#define U_DIFF_P(x) x
#endif
#ifdef NO_DIFF_S
#define U_DIFF_S(x)
#else
#define U_DIFF_S(x) x
#endif
#ifdef NO_DSA_P
#define U_DSA_P(x)
#else
#define U_DSA_P(x) x
#endif
#ifdef NO_DSA_S
#define U_DSA_S(x)
#else
#define U_DSA_S(x) x
#endif
#ifdef NO_MLA
#define U_MLA(x)
#else
#define U_MLA(x) x
#endif
#ifdef NO_SEL
#define U_SEL(x)
#else
#define U_SEL(x) x
#endif
__device__ __forceinline__ int wq_next(unsigned* ctr, volatile LAS unsigned* slot, int wave) {
    const int tid = phase_tid(wave);
    __syncthreads();
    if (tid == 0) *slot = __hip_atomic_fetch_add(ctr, 1u, __ATOMIC_RELAXED, __HIP_MEMORY_SCOPE_AGENT);
    __syncthreads();
    return (int)*slot;
}
__device__ __forceinline__ void wq_request(unsigned* ctr, volatile LAS unsigned* slot, int wave) {
    if (phase_tid(wave) == 0) *slot = __hip_atomic_fetch_add(ctr, 1u, __ATOMIC_RELAXED, __HIP_MEMORY_SCOPE_AGENT);
}
__device__ __forceinline__ int wq_take(volatile LAS unsigned* slot) { __syncthreads(); return (int)*slot; }
__device__ __forceinline__ void phase_b_extra(const P& p, int layer, LAS unsigned char* lds, volatile LAS unsigned* MISC, int wave, int kinds = 15, int rep = 0) {
    unsigned* ctr = (unsigned*)(p.ws + WS_CTL) + CW_WQ + 64 * (2 * layer + 4 * rep);
    const unsigned* aff = (const unsigned*)(p.ws + WS_CTL) + CW_AFF;
    const int NCONV = (layer == 0 && (kinds & 8)) ? 256 : 0;
    constexpr int I_DIFF = 256, I_T8 = I_DIFF + 64, I_SEL = I_T8 + 512, I_QUP = I_SEL + 192, I_KVUP = I_QUP + 256;
    int it = 0;
    for (int idx = wq_next(ctr, MISC + 16, wave); idx < I_KVUP + NCONV; ++it) {
        if (idx < I_DIFF) { const int qb = 15 - (idx >> 4), r = idx & 15;
            if (kinds & 1) { if (aff[r >> 2] == 0u) { U_DIFF_P(attn_unit_pd(p, layer, r >> 2, r & 3, qb, lds, wave)); } else { U_DIFF_S(attn_unit<1>(p, layer, r >> 2, r & 3, qb, lds, wave)); } } }
        else if (idx < I_T8) { if (kinds & 4) run_gemm_unit(lds, p, layer, 2, idx - I_DIFF, 0, wave); }
        else if (idx < I_SEL) { const int j = idx - I_T8, qb = 15 - (j >> 5), s = j & 31;
            if (kinds & 2) { U_SEL(select_unit(p, s >> 3, qb * 16 + 2 * (s & 7), lds, wave)); U_SEL(select_unit(p, s >> 3, qb * 16 + 2 * (s & 7) + 1, lds, wave)); } }
        else if (idx < I_QUP) { const int u = idx - I_SEL; if (kinds & 4) run_gemm_unit(lds, p, layer, 0, u / 3, u % 3, wave); }
        else if (idx < I_KVUP) { const int u = idx - I_QUP; if (kinds & 4) run_gemm_unit(lds, p, layer, 1, u >> 2, u & 3, wave); }
        else { prep_w_range(p, 3, 12, idx - I_KVUP, 256, (float*)lds, phase_tid(wave)); }
        idx = wq_next(ctr, MISC + 16, wave);
    }
}
__device__ __forceinline__ void phase_c(const P& p, int layer, LAS unsigned char* lds, volatile LAS unsigned* MISC, int wave, int kinds = 3, int rep = 0) {
    unsigned* ctr = (unsigned*)(p.ws + WS_CTL) + CW_WQ + 64 * (2 * layer + 1 + 4 * rep);
    const unsigned* aff = (const unsigned*)(p.ws + WS_CTL) + CW_AFF;
    int it = 0;
    for (int idx = wq_next(ctr, MISC + 16, wave); idx < 16 * 48; ++it) {
        const int lvl = idx / 48, r = idx % 48, qb = 15 - lvl;
        if (r < 32) { if (kinds & 1) { U_MLA(attn_unit_q<0>(p, layer, r >> 3, r & 7, qb, lds, wave)); } }
        else if (kinds & 2) { const int s = r - 32; if (aff[s >> 2] == 0u) { U_DSA_P(attn_unit_q<2>(p, layer, s >> 2, s & 3, qb, lds, wave)); } else { U_DSA_S(attn_unit<2>(p, layer, s >> 2, s & 3, qb, lds, wave)); } }
        idx = wq_next(ctr, MISC + 16, wave);
    }
}
constexpr int NPH = 13;
struct Args { P p; int ph_lo, ph_hi; };
__global__ void __launch_bounds__(NWAVES * 64, 2) fwd(Args a) {
    extern __shared__ __attribute__((aligned(16))) unsigned char lds_raw[];
    LAS unsigned char* lds = (LAS unsigned char*)lds_raw;
    const P& p = a.p;
    const int wave = __builtin_amdgcn_readfirstlane(threadIdx.x >> 6);
    volatile LAS unsigned* MISC = (volatile LAS unsigned*)(lds + MISC_OFF);
    { const int tid = phase_tid(wave);
    for (int u = tid; u < (LDS_BYTES - LDSCTL_OFF) / 4; u += NWAVES * 64) ((LAS unsigned*)(lds + LDSCTL_OFF))[u] = 0u; }
    __syncthreads();
    const int lo = a.ph_lo, hi = a.ph_hi;
    unsigned* ctl = (unsigned*)(p.ws + WS_CTL);
    XcdBarrier bar; bar.bar = ctl + CW_BAR; bar.x = 0; bar.st = nullptr;
    if (hi - lo > 1) bar = xcd_barrier_post(ctl + CW_BAR, MISC + 8, phase_tid(wave));
#define IN(k) (lo <= (k) && (k) < hi)
#ifndef PROBE
#define PROBE 0
#endif
#define PBAR() xcd_barrier(bar, phase_tid(wave))
#define LOPQ int ll = l; asm volatile("" : "+s"(ll))
#define SEAM(k) do { if (IN(k) && IN((k) + 1)) xcd_barrier(bar, phase_tid(wave)); } while (0)

    for (int rep = 0; rep < (PROBE == 1 ? 2 : 1); ++rep) { if (rep) PBAR();
    if (IN(0)) {
        const int tid = phase_tid(wave), lane = tid & 63;
        float* scr = (float*)lds_raw;
        prep_w_range(p, 0, 3, (int)blockIdx.x, (int)gridDim.x, scr, tid);
        const int gw = blockIdx.x * NWAVES + wave, ngw = gridDim.x * NWAVES;
        for (int r = gw; r < T; r += ngw) prep_x_row(p, r, lane);
        for (int i = blockIdx.x * (NWAVES * 64) + tid; i < T * 16; i += gridDim.x * NWAVES * 64) prep_rope(p, i);
        for (int i = blockIdx.x * (NWAVES * 64) + tid; i < T; i += gridDim.x * NWAVES * 64) { const int bb = i >> 12; if ((PROBE == 30) || p.pos[i] - p.pos[bb * S] != (i & (S - 1))) atomicOr((unsigned*)(p.ws + WS_CTL) + CW_AFF + bb, 1u); }
        if (blockIdx.x == 0) for (int i = tid; i < 129 * 8; i += NWAVES * 64) prep_lut(p, i);
        if (wave == 0) {
            for (int blk = blockIdx.x; blk < T / 64; blk += gridDim.x) {
                const int v = p.pos[blk * 64 + lane]; int mx = v, mn = v;
#pragma unroll
                for (int o = 1; o < 32; o <<= 1) { mx = max(mx, __shfl_xor(mx, o)); mn = min(mn, __shfl_xor(mn, o)); }
                const int mx2 = max(mx, __shfl_xor(mx, 32));
                if ((lane & 31) == 0) ((int*)(p.ws + WS_MISC + MISC_PMIN32))[blk * 2 + (lane >> 5)] = mn;
                if (lane == 0) ((int*)(p.ws + WS_MISC + MISC_PMAX64))[blk] = mx2;
            }
        }
    }
    }
    if (PROBE == 13) { for (int i = 0; i < 10; ++i) PBAR(); }
    SEAM(0);
    for (int l = 0; l < DEPTH; ++l) {
        const int pb = 1 + 6 * l;
        for (int rep = 0; rep < (PROBE == 2 ? 2 : 1); ++rep) { if (rep) PBAR(); if (IN(pb + 0)) { LOPQ; run_gemm<EPI_IN>(lds, p, ll, WS_XB, WS_WIN + ll * SZ_WIN, T, 2048, DM, wave); } }
        if (PROBE == 22 && IN(pb + 0)) { PBAR(); LOPQ; run_gemm_none(lds, p, WS_XB, WS_WIN + ll * SZ_WIN, T, 2048, DM, wave); }
        SEAM(pb + 0);
        if (IN(pb + 1)) {
            { LOPQ; phase_b_extra(p, ll, lds, MISC, wave); }
            if (PROBE == 20) { PBAR(); LOPQ; phase_b_extra(p, ll, lds, MISC, wave, 7, 1); }
            if (PROBE == 24) { PBAR(); LOPQ; phase_b_extra(p, ll, lds, MISC, wave, 3, 1); }
            if (PROBE == 25) { PBAR(); LOPQ; phase_b_extra(p, ll, lds, MISC, wave, 5, 1); }
            if (PROBE == 3) { PBAR(); LOPQ; phase_b_extra(p, ll, lds, MISC, wave, 4, 1); }
            if (PROBE == 4) { PBAR(); LOPQ; phase_b_extra(p, ll, lds, MISC, wave, 1, 1); }
            if (PROBE == 9) { PBAR(); LOPQ; phase_b_extra(p, ll, lds, MISC, wave, 2, 1); }
        }
        SEAM(pb + 1);
        if (IN(pb + 2)) {
            { LOPQ; phase_c(p, ll, lds, MISC, wave); }
            if (PROBE == 21) { PBAR(); LOPQ; phase_c(p, ll, lds, MISC, wave, 3, 1); }
            if (PROBE == 5) { PBAR(); LOPQ; phase_c(p, ll, lds, MISC, wave, 1, 1); }
            if (PROBE == 10) { PBAR(); LOPQ; phase_c(p, ll, lds, MISC, wave, 2, 1); }
        }
        SEAM(pb + 2);
        for (int rep = 0; rep < ((PROBE == 6 && l == 0) ? 2 : 1); ++rep) { if (rep) PBAR(); if (IN(pb + 3)) { LOPQ; run_gemm<EPI_OUT>(lds, p, ll, WS_MIX, WS_WOUT + ll * SZ_WOUT, T, DM, DM, wave); } }
        SEAM(pb + 3);
        for (int rep = 0; rep < (PROBE == 7 ? 2 : 1); ++rep) { if (rep) PBAR(); if (IN(pb + 4)) { LOPQ; run_gemm<EPI_UP>(lds, p, ll, WS_XB, WS_WUP + ll * SZ_WUP, T, DFF, DM, wave); } }
        SEAM(pb + 4);
        if (IN(pb + 5)) { LOPQ; if (ll + 1 < DEPTH || gridDim.x != 256) run_gemm<EPI_DOWN>(lds, p, ll, WS_U, WS_WDN + ll * SZ_WDN, T, DM, DFF, wave); else run_gemm_final(lds, p, WS_U, WS_WDN + ll * SZ_WDN, wave); }
        SEAM(pb + 5);
    }
    if (gridDim.x != 256 && lo <= 12 && 12 < hi) { xcd_barrier(bar, phase_tid(wave));
        const int lane = phase_tid(wave) & 63;
        const int gw = blockIdx.x * NWAVES + wave, ngw = gridDim.x * NWAVES;
        for (int row = gw; row < T; row += ngw) {
            float s = ((const float*)(p.ws + WS_RSA))[(size_t)row * 32 + (lane & 31)];
#pragma unroll
            for (int o = 1; o < 32; o <<= 1) s += __shfl_xor(s, o);
            const float rs = 1.0f / sqrtf(s / (float)DM + EPS);
            const bf16_t* xb = (const bf16_t*)(p.ws + WS_XB) + (size_t)row * DM + lane * 8;
            float* o = p.out + (size_t)row * DM + lane * 8;
#pragma unroll
            for (int j = 0; j < 2; ++j) { float v[8]; unpk8(*(const GAS u32x4*)(xb + 512 * j), v);
                const f32x4 g0 = *(const GAS f32x4*)(p.norm_final + lane * 8 + 512 * j), g1 = *(const GAS f32x4*)(p.norm_final + lane * 8 + 512 * j + 4);
                *(GAS f32x4*)(o + 512 * j) = (f32x4){v[0] * rs * g0.x, v[1] * rs * g0.y, v[2] * rs * g0.z, v[3] * rs * g0.w};
                *(GAS f32x4*)(o + 512 * j + 4) = (f32x4){v[4] * rs * g1.x, v[5] * rs * g1.y, v[6] * rs * g1.z, v[7] * rs * g1.w}; }
        }
    }
#undef IN
#undef SEAM
}
static P make_params(void* const* d_in, void* d_out, void* d_ws) {
    P p{};
    p.x = (const float*)d_in[0]; p.pos = (const int*)d_in[1]; p.rel_bias = (const float*)d_in[2]; p.norm_attn = (const float*)d_in[3]; p.w_in = (const float*)d_in[4];
    p.q_norm = (const float*)d_in[5]; p.w_uq = (const float*)d_in[6]; p.kv_norm = (const float*)d_in[7]; p.w_ukv = (const float*)d_in[8]; p.diff_lambda = (const float*)d_in[9];
    p.diff_subln = (const float*)d_in[10]; p.w_out = (const float*)d_in[11]; p.norm_mlp = (const float*)d_in[12]; p.w_up = (const float*)d_in[13]; p.w_down = (const float*)d_in[14];
    p.norm_final = (const float*)d_in[15]; p.out = (float*)d_out; p.ws = (unsigned char*)d_ws;
    return p;
}
extern "C" void kernel_launch(void* const* d_in, const int* in_sizes, int n_in, void* d_out, int out_size, void* d_ws, size_t ws_size, hipStream_t stream) {
    static int grid = 0;
    if (!grid) {
        if (n_in != 16 || out_size != T * DM || ws_size < 256 * MiB) { fprintf(stderr, "kernel_launch: unexpected shapes n_in %d out %d ws %zu\n", n_in, out_size, ws_size); grid = -1; return; }
        if (hipFuncSetAttribute((const void*)fwd, hipFuncAttributeMaxDynamicSharedMemorySize, LDS_BYTES) != hipSuccess) { fprintf(stderr, "kernel_launch: hipFuncSetAttribute failed\n"); grid = -1; return; }
        int dev = 0, cus = 0, per_cu = 0;
        if (hipGetDevice(&dev) != hipSuccess || hipDeviceGetAttribute(&cus, hipDeviceAttributeMultiprocessorCount, dev) != hipSuccess) { grid = -1; return; }
        if (hipOccupancyMaxActiveBlocksPerMultiprocessor(&per_cu, (const void*)fwd, NWAVES * 64, LDS_BYTES) != hipSuccess || per_cu < 1) fprintf(stderr, "kernel_launch: occupancy query says %d\n", per_cu);
        (void)hipGetLastError();
        grid = cus;
    }
    if (grid < 0) return;
    if (hipMemsetAsync((char*)d_ws + WS_CTL, 0, CTL_ZERO_BYTES, stream) != hipSuccess) return;
    Args a{}; a.p = make_params(d_in, d_out, d_ws); a.ph_lo = 0; a.ph_hi = NPH;
    hipLaunchKernelGGL(fwd, dim3(grid), dim3(NWAVES * 64), LDS_BYTES, stream, a);
}
```
